# Optimizing an MI355X kernel written in HIP

```python
import jax, jax.numpy as jnp
from jax import lax
import numpy as np

D_MODEL = 1024
BATCH = 2
SEQ = 8192
DEPTH = 1

D_FF = 2816
D_A = D_MODEL
N_GROUPS_A = 8
CONV_K = 3
D_B = D_MODEL
N_HEADS_B = 8
DH_B = D_B // N_HEADS_B
CHUNK = 128
N_SUBLAYERS = 3
EPS = 1e-6
MACARON_W = 0.5
MIX_IN_WIDTHS = (D_MODEL, D_MODEL, D_A, D_A, D_A, D_B, D_B)
MIX_IN = sum(MIX_IN_WIDTHS)

kernel_name = "hybrid_conv_gmlp_macaron_adaln"


def rmsnorm(x, g):
    xf = x.astype(jnp.float32)
    y = xf * lax.rsqrt(jnp.mean(xf * xf, axis=-1, keepdims=True) + EPS)
    return (y * g.astype(jnp.float32)).astype(x.dtype)


def layernorm(x, g, b):
    xf = x.astype(jnp.float32)
    mu = jnp.mean(xf, axis=-1, keepdims=True)
    var = jnp.mean(jnp.square(xf - mu), axis=-1, keepdims=True)
    y = (xf - mu) * lax.rsqrt(var + EPS)
    return (y * g.astype(jnp.float32) + b.astype(jnp.float32)).astype(x.dtype)


def modulate(h, shift, scale):
    return h * (1.0 + scale[:, None, :]) + shift[:, None, :]


def swiglu(h, w_in, w_out):
    a, b = jnp.split(h @ w_in, 2, axis=-1)
    return (jax.nn.silu(a) * b) @ w_out


def causal_dwconv(z, w):
    k, ch = w.shape
    return lax.conv_general_dilated(
        z, w[:, None, :].astype(z.dtype), window_strides=(1,),
        padding=[(k - 1, 0)], dimension_numbers=("NWC", "WIO", "NWC"),
        feature_group_count=ch)


def chunked_spatial_gate(u, v, w_spatial, b_spatial):
    bsz, s, _ = v.shape
    mask = jnp.tril(jnp.ones((CHUNK, CHUNK), dtype=w_spatial.dtype))
    w_sp = w_spatial * mask[None]
    vh = v.reshape(bsz, s // CHUNK, CHUNK, N_HEADS_B, DH_B)
    sv = jnp.einsum("hts,bnshd->bnthd", w_sp, vh) + b_spatial.T[None, None, :, :, None]
    return u * sv.reshape(bsz, s, D_B)


def setup_inputs(seed: int = 0) -> dict:
    key = jax.random.key(seed)
    ks = jax.random.split(key, 24)
    f32 = jnp.float32
    n = lambda k, shape, s: jax.random.normal(k, shape, f32) * s
    gain = lambda k, d: 1.0 + 0.02 * jax.random.normal(k, (d,), f32)
    return {
        "x": jax.random.normal(ks[0], (BATCH, SEQ, D_MODEL), f32),
        "c": jax.random.normal(ks[1], (BATCH, D_MODEL), f32),
        "w_ada": n(ks[2], (D_MODEL, N_SUBLAYERS * 3 * D_MODEL), 0.5 * D_MODEL ** -0.5),
        "b_ada": n(ks[3], (N_SUBLAYERS * 3 * D_MODEL,), 0.02),
        "g_ffn1": gain(ks[4], D_MODEL),
        "w_ffn1_in": n(ks[5], (D_MODEL, 2 * D_FF), D_MODEL ** -0.5),
        "w_ffn1_out": n(ks[6], (D_FF, D_MODEL), D_FF ** -0.5),
        "g_mix": gain(ks[7], D_MODEL),
        "w_mix_in": n(ks[8], (D_MODEL, MIX_IN), D_MODEL ** -0.5),
        "conv_w": n(ks[9], (CONV_K, D_A), CONV_K ** -0.5),
        "ln_v_g": gain(ks[10], D_B),
        "ln_v_b": n(ks[11], (D_B,), 0.02),
        "w_spatial": n(ks[12], (N_HEADS_B, CHUNK, CHUNK), CHUNK ** -0.5),
        "b_spatial": 1.0 + n(ks[13], (N_HEADS_B, CHUNK), 0.02),
        "w_a_out": n(ks[14], (D_A, D_MODEL), D_A ** -0.5),
        "w_b_out": n(ks[15], (D_B, D_MODEL), D_B ** -0.5),
        "w_mix_out": n(ks[16], (D_MODEL, D_MODEL), D_MODEL ** -0.5),
        "g_ffn2": gain(ks[17], D_MODEL),
        "w_ffn2_in": n(ks[18], (D_MODEL, 2 * D_FF), D_MODEL ** -0.5),
        "w_ffn2_out": n(ks[19], (D_FF, D_MODEL), D_FF ** -0.5),
        "g_final": gain(ks[20], D_MODEL),
    }


def reference(x, c, w_ada, b_ada, g_ffn1, w_ffn1_in, w_ffn1_out, g_mix, w_mix_in,
              conv_w, ln_v_g, ln_v_b, w_spatial, b_spatial, w_a_out, w_b_out,
              w_mix_out, g_ffn2, w_ffn2_in, w_ffn2_out, g_final):
    split_pts = list(np.cumsum(MIX_IN_WIDTHS)[:-1])
    for _ in range(DEPTH):
        ada = jax.nn.silu(c) @ w_ada + b_ada
        (sh1, sc1, gt1, sh2, sc2, gt2, sh3, sc3, gt3) = jnp.split(ada, 3 * N_SUBLAYERS, axis=-1)

        h = modulate(rmsnorm(x, g_ffn1), sh1, sc1)
        x = x + MACARON_W * gt1[:, None, :] * swiglu(h, w_ffn1_in, w_ffn1_out)

        h = modulate(rmsnorm(x, g_mix), sh2, sc2)
        p = h @ w_mix_in
        gate_a, gate_b, b_a, c_a, x_a, u_b, v_b = jnp.split(p, split_pts, axis=-1)
        y_a = (b_a * causal_dwconv(c_a * x_a, conv_w)) @ w_a_out
        u_b = jax.nn.gelu(u_b)
        v_b = layernorm(jax.nn.gelu(v_b), ln_v_g, ln_v_b)
        y_b = chunked_spatial_gate(u_b, v_b, w_spatial, b_spatial) @ w_b_out
        m = (jax.nn.sigmoid(gate_a) * y_a + jax.nn.sigmoid(gate_b) * y_b) @ w_mix_out
        x = x + gt2[:, None, :] * m

        h = modulate(rmsnorm(x, g_ffn2), sh3, sc3)
        x = x + MACARON_W * gt3[:, None, :] * swiglu(h, w_ffn2_in, w_ffn2_out)
    return rmsnorm(x, g_final)
```

```cpp
#include <hip/hip_runtime.h>
#include <cstdio>
#include <cstdint>
namespace pg8 {
#define PG8_LAS __attribute__((address_space(3)))
typedef unsigned short bf16_t;
typedef short bf16x8 __attribute__((ext_vector_type(8)));
typedef float f32x4 __attribute__((ext_vector_type(4)));
typedef unsigned u32x4 __attribute__((ext_vector_type(4)));
constexpr int BM = 256, BK = 64, HALF = 128, HTB = HALF * BK * 2  , STAGE_BYTES = 8 * HTB, NXCD = 8, WGM = 8;

__host__ __device__ __forceinline__ int lds_byte(int r, int c) { const int st = (r >> 4) * 2 + (c >> 5), rr = r & 15, cc = c & 31, ob = rr * 64 + cc * 2; return st * 1024 + (ob ^ (((ob >> 9) & 1) << 5)); }
__host__ __device__ __forceinline__ void stage_rc(int b, int& R, int& C) { const int st = b / 1024, sb = b % 1024, swz = sb ^ (((sb >> 9) & 1) << 5); R = (st >> 1) * 16 + swz / 64; C = (st & 1) * 32 + (swz % 64) / 2; }
__host__ __device__ __forceinline__ int perm32(int rho) { const int n = rho >> 4, i = rho & 15; return 8 * (i >> 2) + 4 * n + (i & 3); }

struct Unit { int pm, pn; };
struct Gemm { const bf16_t* A; const bf16_t* Bt; int M, N, K; };

struct StaticOrder {
    int nM, nN, nwg, G, c;
    __host__ __device__ void init(int M, int N, int G_, int c_) { nM = M / BM; nN = N / BM; nwg = nM * nN; G = G_; c = c_; }
    __host__ __device__ bool next(int i, Unit& u) const {
        const long L = (long)i * G + c; if (L >= nwg) return false;
        int wgid = (int)L; { const int q = nwg / NXCD, r = nwg % NXCD, xcd = wgid % NXCD, off = wgid / NXCD; wgid = (xcd < r ? xcd * (q + 1) : r * (q + 1) + (xcd - r) * q) + off; }
        const int nig = WGM * nN, gid = wgid / nig, fm = gid * WGM, gsz = (nM - fm) < WGM ? (nM - fm) : WGM;
        u.pm = fm + ((wgid % nig) % gsz); u.pn = (wgid % nig) / gsz; return true;
    }
    __device__ __forceinline__ void a_ready(const Unit&) const {}
    __device__ __forceinline__ void done(const Unit&) const {}
};

typedef __bf16 bf16x2_hw __attribute__((ext_vector_type(2)));
typedef float f32x2_hw __attribute__((ext_vector_type(2)));
__device__ __forceinline__ unsigned cvt_pk_bf16(float lo, float hi) { const f32x2_hw f = {lo, hi}; return __builtin_bit_cast(unsigned, __builtin_convertvector(f, bf16x2_hw)); }
typedef float f32x2 __attribute__((ext_vector_type(2)));
template <class Epi, class Sched, bool ALIGN_EPI = false, bool SP2 = false>
__device__ __forceinline__ void gemm_phase(PG8_LAS unsigned char* lds, const Gemm g, const Sched& S, const Epi& E) {
    const int tid = threadIdx.x, wid = __builtin_amdgcn_readfirstlane(tid >> 6), lane = tid & 63, wr = wid >> 2, wc = wid & 3, fr = lane & 15, fq = lane >> 4;
    const int K = g.K, nt = K / BK;
    unsigned voffA[2], voffB[2];
#pragma unroll
    for (int i = 0; i < 2; ++i) { int R, C; stage_rc(tid * 16 + i * 8192, R, C); const int Rb = Epi::PERM ? ((R & ~31) + perm32(R & 31)) : R;
        voffA[i] = (unsigned)(R * K + C) * 2u; voffB[i] = (unsigned)(Rb * K + C) * 2u; }
    const size_t kstep = (size_t)(BK * 2);
    const size_t hstep = (size_t)HALF * K * 2;
    const size_t tstep = 2 * hstep;
    const unsigned ldsw = (unsigned)wid * 1024u;
    const int aoff = lds_byte(wr * 64 + fr, fq * 8), boff = lds_byte(wc * 32 + fr, fq * 8);
#define PG8_SA(b, h) (((b) * 2 + (h)) * HTB)
#define PG8_SB(b, h) ((4 + (b) * 2 + (h)) * HTB)
#define PG8_STAGE(bufoff, gbase, voff) do { _Pragma("unroll") for (int _i = 0; _i < 2; ++_i) \
        __builtin_amdgcn_global_load_lds((const unsigned*)((const char*)(gbase) + (voff)[_i]), (PG8_LAS unsigned*)(lds + (bufoff) + ldsw + _i * 8192), 16, 0, 0); } while (0)
#define PG8_LDA(dst, b, h) do { _Pragma("unroll") for (int m = 0; m < 4; ++m) _Pragma("unroll") for (int k = 0; k < 2; ++k) dst[m][k] = *(const PG8_LAS bf16x8*)(lds + PG8_SA(b, h) + aoff + m * 2048 + k * 1024); } while (0)
#define PG8_LDB(dst, b, h) do { _Pragma("unroll") for (int n = 0; n < 2; ++n) _Pragma("unroll") for (int k = 0; k < 2; ++k) dst[n][k] = *(const PG8_LAS bf16x8*)(lds + PG8_SB(b, h) + boff + n * 2048 + k * 1024); } while (0)
#define PG8_MMA(ai, bj, At, Bt) do { __builtin_amdgcn_s_setprio(1); _Pragma("unroll") for (int m = 0; m < 4; ++m) _Pragma("unroll") for (int n = 0; n < 2; ++n) _Pragma("unroll") for (int k = 0; k < 2; ++k) \
        acc[ai][bj][m][n] = __builtin_amdgcn_mfma_f32_16x16x32_bf16(Bt[n][k], At[m][k], acc[ai][bj][m][n], 0, 0, 0); __builtin_amdgcn_s_setprio(0); } while (0)
#define PG8_WAIT_V(n) asm volatile("s_waitcnt vmcnt(" #n ")" ::: "memory")
#define PG8_WAIT_L(n) asm volatile("s_waitcnt lgkmcnt(" #n ")" ::: "memory")
#define PG8_BAR __builtin_amdgcn_s_barrier()
#define PG8_SCHED __builtin_amdgcn_sched_barrier(0)
    Unit cur, nxt; int ui = 0;
    if (!S.next(0, cur)) return;
    f32x4 acc[2][2][4][2];
#pragma unroll
    for (int a = 0; a < 2; ++a)
#pragma unroll
        for (int b = 0; b < 2; ++b)
#pragma unroll
            for (int m = 0; m < 4; ++m)
#pragma unroll
                for (int n = 0; n < 2; ++n) acc[a][b][m][n] = (f32x4){0.f, 0.f, 0.f, 0.f};
    bf16x8 At[4][2], B0[2][2], B1[2][2];
    const char* cA = (const char*)g.A + (size_t)cur.pm * tstep; const char* cB = (const char*)g.Bt + (size_t)cur.pn * tstep;
    S.a_ready(cur);
    if constexpr (SP2) {
        PG8_STAGE(PG8_SB(0, 0), cB, voffB); PG8_STAGE(PG8_SB(0, 1), cB + hstep, voffB); PG8_STAGE(PG8_SA(0, 0), cA, voffA); PG8_STAGE(PG8_SA(0, 1), cA + hstep, voffA);
        if (wr == 1) PG8_BAR;
        PG8_WAIT_V(2); PG8_BAR;
        PG8_STAGE(PG8_SB(1, 0), cB + kstep, voffB); PG8_STAGE(PG8_SA(1, 0), cA + kstep, voffA); PG8_STAGE(PG8_SB(1, 1), cB + hstep + kstep, voffB);
        PG8_WAIT_V(6); PG8_BAR;
    } else {
        PG8_STAGE(PG8_SB(0, 0), cB, voffB); PG8_STAGE(PG8_SA(0, 0), cA, voffA); PG8_STAGE(PG8_SB(0, 1), cB + hstep, voffB); PG8_STAGE(PG8_SA(0, 1), cA + hstep, voffA);
        if (wr == 1) PG8_BAR;
        PG8_WAIT_V(4); PG8_BAR;
        PG8_STAGE(PG8_SB(1, 0), cB + kstep, voffB); PG8_STAGE(PG8_SA(1, 0), cA + kstep, voffA); PG8_STAGE(PG8_SB(1, 1), cB + hstep + kstep, voffB);
        PG8_WAIT_V(6); PG8_BAR;
    }
    for (;;) {
        const bool has_next = S.next(ui + 1, nxt);
        const char* nA = has_next ? (const char*)g.A + (size_t)nxt.pm * tstep : cA; const char* nB = has_next ? (const char*)g.Bt + (size_t)nxt.pn * tstep : cB;
        for (int t = 0; t < nt; t += 2) {
            const bool last = (t == nt - 2);
            const char* a1 = cA + (size_t)(t + 1) * kstep;
            const char* a2 = last ? nA : cA + (size_t)(t + 2) * kstep; const char* b2 = last ? nB : cB + (size_t)(t + 2) * kstep;
            const char* a3 = a2 + kstep; const char* b3 = b2 + kstep;
            if (last && has_next) S.a_ready(nxt);
            if constexpr (SP2) {
            PG8_LDB(B0, 0, 0); PG8_LDB(B1, 0, 1); PG8_SCHED; PG8_LDA(At, 0, 0); PG8_STAGE(PG8_SA(1, 1), a1 + hstep, voffA);
            PG8_WAIT_V(8); PG8_WAIT_L(0); PG8_BAR; PG8_MMA(0, 0, At, B0); PG8_MMA(0, 1, At, B1); PG8_BAR; PG8_SCHED;
            PG8_LDA(At, 0, 1); PG8_STAGE(PG8_SB(0, 0), b2, voffB); PG8_STAGE(PG8_SB(0, 1), b2 + hstep, voffB); PG8_STAGE(PG8_SA(0, 0), a2, voffA);
            PG8_WAIT_V(8); PG8_WAIT_L(0); PG8_BAR; PG8_MMA(1, 0, At, B0); PG8_MMA(1, 1, At, B1); PG8_BAR; PG8_SCHED;
            PG8_LDB(B0, 1, 0); PG8_LDB(B1, 1, 1); PG8_SCHED; PG8_LDA(At, 1, 0); PG8_STAGE(PG8_SA(0, 1), a2 + hstep, voffA);
            PG8_WAIT_V(8); PG8_WAIT_L(0); PG8_BAR; PG8_MMA(0, 0, At, B0); PG8_MMA(0, 1, At, B1); PG8_BAR; PG8_SCHED;
            PG8_LDA(At, 1, 1); PG8_STAGE(PG8_SB(1, 0), b3, voffB); PG8_STAGE(PG8_SB(1, 1), b3 + hstep, voffB); PG8_STAGE(PG8_SA(1, 0), a3, voffA);
            PG8_WAIT_V(8); PG8_WAIT_L(0); PG8_BAR; PG8_MMA(1, 0, At, B0); PG8_MMA(1, 1, At, B1); PG8_BAR; PG8_SCHED;
            } else {
            PG8_LDB(B0, 0, 0); PG8_SCHED; PG8_LDA(At, 0, 0); PG8_STAGE(PG8_SA(1, 1), a1 + hstep, voffA);
            PG8_WAIT_L(8); PG8_BAR; PG8_WAIT_L(0); PG8_MMA(0, 0, At, B0); PG8_BAR; PG8_SCHED;
            PG8_LDB(B1, 0, 1); PG8_STAGE(PG8_SB(0, 0), b2, voffB);
            PG8_BAR; PG8_WAIT_L(0); PG8_MMA(0, 1, At, B1); PG8_BAR;
            PG8_LDA(At, 0, 1); PG8_STAGE(PG8_SA(0, 0), a2, voffA);
            PG8_BAR; PG8_WAIT_L(0); PG8_MMA(1, 0, At, B0); PG8_BAR; PG8_SCHED;
            PG8_STAGE(PG8_SB(0, 1), b2 + hstep, voffB);
            PG8_WAIT_V(6); PG8_BAR; PG8_MMA(1, 1, At, B1); PG8_BAR;
            PG8_LDB(B0, 1, 0); PG8_SCHED; PG8_LDA(At, 1, 0); PG8_STAGE(PG8_SA(0, 1), a2 + hstep, voffA);
            PG8_WAIT_L(8); PG8_BAR; PG8_WAIT_L(0); PG8_MMA(0, 0, At, B0); PG8_BAR; PG8_SCHED;
            PG8_LDB(B1, 1, 1); PG8_STAGE(PG8_SB(1, 0), b3, voffB);
            PG8_BAR; PG8_WAIT_L(0); PG8_MMA(0, 1, At, B1); PG8_BAR;
            PG8_LDA(At, 1, 1); PG8_STAGE(PG8_SA(1, 0), a3, voffA);
            PG8_BAR; PG8_WAIT_L(0); PG8_MMA(1, 0, At, B0); PG8_BAR; PG8_SCHED;
            PG8_STAGE(PG8_SB(1, 1), b3 + hstep, voffB);
            PG8_WAIT_V(6); PG8_BAR; PG8_MMA(1, 1, At, B1); PG8_BAR;
            }
        }
        if constexpr (ALIGN_EPI) { if (wr == 0) PG8_BAR; }
        if constexpr (!Epi::AFTER_DRAIN) { E(acc, cur, wr, wc, fr, fq); S.done(cur); }
        if (!has_next) break;
#pragma unroll
        for (int a = 0; a < 2; ++a)
#pragma unroll
            for (int b = 0; b < 2; ++b)
#pragma unroll
                for (int m = 0; m < 4; ++m)
#pragma unroll
                    for (int n = 0; n < 2; ++n) acc[a][b][m][n] = (f32x4){0.f, 0.f, 0.f, 0.f};
        cur = nxt; cA = nA; cB = nB; ++ui;
        if constexpr (ALIGN_EPI) { if (wr == 1) PG8_BAR; }
    }
    PG8_WAIT_V(0);
    if constexpr (!ALIGN_EPI) { if (wr == 0) PG8_BAR; }
    PG8_BAR;
    if constexpr (Epi::AFTER_DRAIN) { E.fused(acc, cur, wr, wc, fr, fq, lds, wid, lane); S.done(cur); }
#undef PG8_SA
#undef PG8_SB
#undef PG8_STAGE
#undef PG8_LDA
#undef PG8_LDB
#undef PG8_MMA
#undef PG8_WAIT_V
#undef PG8_WAIT_L
#undef PG8_BAR
#undef PG8_SCHED
}
__device__ __forceinline__ float fsig(float x) { return __builtin_amdgcn_rcpf(1.0f + __builtin_amdgcn_exp2f(-1.44269504089f * x)); }
__device__ __forceinline__ float fsilu(float x) { return x * fsig(x); }
__device__ __forceinline__ float fgelu(float x) { const float u = 1.5957691216057308f * (x + 0.044715f * x * x * x); return x * fsig(u); }
__device__ __forceinline__ void store8(bf16_t* p, f32x4 a, f32x4 b) { u32x4 w; w.x = cvt_pk_bf16(a[0], a[1]); w.y = cvt_pk_bf16(a[2], a[3]); w.z = cvt_pk_bf16(b[0], b[1]); w.w = cvt_pk_bf16(b[2], b[3]); *(u32x4*)p = w; }
__device__ __forceinline__ void load8(const bf16_t* p, f32x4& a, f32x4& b) { const u32x4 w = *(const u32x4*)p;
    a[0] = __uint_as_float(w.x << 16); a[1] = __uint_as_float(w.x & 0xffff0000u); a[2] = __uint_as_float(w.y << 16); a[3] = __uint_as_float(w.y & 0xffff0000u);
    b[0] = __uint_as_float(w.z << 16); b[1] = __uint_as_float(w.z & 0xffff0000u); b[2] = __uint_as_float(w.w << 16); b[3] = __uint_as_float(w.w & 0xffff0000u); }
#define EPI_FOR_ROWS _Pragma("unroll") for (int ai = 0; ai < 2; ++ai) _Pragma("unroll") for (int m = 0; m < 4; ++m)

struct EpiSwiglu { static constexpr bool PERM = true, AFTER_DRAIN = false; bf16_t* O; int ldc;
    __device__ __forceinline__ void operator()(const f32x4 (&acc)[2][2][4][2], const Unit& u, int wr, int wc, int fr, int fq) const {
        const int row0 = u.pm * BM + wr * 64 + fr, col0 = u.pn * HALF + wc * 32 + 8 * fq;
        EPI_FOR_ROWS { bf16_t* rowp = O + (size_t)(row0 + ai * HALF + m * 16) * ldc + col0; f32x4 v0, v1;
#pragma unroll
            for (int e = 0; e < 4; ++e) { v0[e] = fsilu(acc[ai][0][m][0][e]) * acc[ai][1][m][0][e]; v1[e] = fsilu(acc[ai][0][m][1][e]) * acc[ai][1][m][1][e]; }
            store8(rowp, v0, v1); }
    }
};
struct EpiMixA { static constexpr bool PERM = true, AFTER_DRAIN = false; bf16_t *BA, *Z, *U, *GV; float* vst;
    __device__ __forceinline__ void operator()(const f32x4 (&acc)[2][2][4][2], const Unit& u, int wr, int wc, int fr, int fq) const {
        const int row0 = u.pm * BM + wr * 64 + fr, pn = u.pn, cw = wc * 32 + 8 * fq;
        if (pn < 4) {
            EPI_FOR_ROWS { bf16_t* rowp = BA + (size_t)(row0 + ai * HALF + m * 16) * 1024 + pn * 256 + cw;
#pragma unroll
                for (int bj = 0; bj < 2; ++bj) store8(rowp + bj * HALF, acc[ai][bj][m][0], acc[ai][bj][m][1]); }
        } else if (pn < 12) {
            EPI_FOR_ROWS { bf16_t* rowp = Z + (size_t)(row0 + ai * HALF + m * 16) * 1024 + (pn - 4) * HALF + cw;
                store8(rowp, acc[ai][0][m][0] * acc[ai][1][m][0], acc[ai][0][m][1] * acc[ai][1][m][1]); }
        } else if (pn < 16) {
            EPI_FOR_ROWS { bf16_t* rowp = U + (size_t)(row0 + ai * HALF + m * 16) * 1024 + (pn - 12) * 256 + cw;
#pragma unroll
                for (int bj = 0; bj < 2; ++bj) { f32x4 v0, v1;
#pragma unroll
                    for (int e = 0; e < 4; ++e) { v0[e] = fgelu(acc[ai][bj][m][0][e]); v1[e] = fgelu(acc[ai][bj][m][1][e]); }
                    store8(rowp + bj * HALF, v0, v1); } }
        } else {
            EPI_FOR_ROWS { const int row = row0 + ai * HALF + m * 16; bf16_t* rowp = GV + (size_t)row * 1024 + (pn - 16) * 256 + cw; float s = 0.f, q = 0.f;
#pragma unroll
                for (int bj = 0; bj < 2; ++bj) { f32x4 v0, v1;
#pragma unroll
                    for (int e = 0; e < 4; ++e) { v0[e] = fgelu(acc[ai][bj][m][0][e]); v1[e] = fgelu(acc[ai][bj][m][1][e]); s += v0[e] + v1[e]; q += v0[e] * v0[e] + v1[e] * v1[e]; }
                    store8(rowp + bj * HALF, v0, v1); }
                s += __shfl_xor(s, 16); s += __shfl_xor(s, 32); q += __shfl_xor(q, 16); q += __shfl_xor(q, 32);
                if (fq == 0) *(f32x2*)(vst + ((size_t)row * 16 + (pn - 16) * 4 + wc) * 2) = (f32x2){s, q}; }
        }
    }
};
struct EpiGates { static constexpr bool PERM = true, AFTER_DRAIN = false; bf16_t *SGA, *SGB;
    __device__ __forceinline__ void operator()(const f32x4 (&acc)[2][2][4][2], const Unit& u, int wr, int wc, int fr, int fq) const {
        const int row0 = u.pm * BM + wr * 64 + fr, pn = u.pn; bf16_t* base = (pn < 4 ? SGA : SGB) + (pn & 3) * 256 + wc * 32 + 8 * fq;
        EPI_FOR_ROWS { bf16_t* rowp = base + (size_t)(row0 + ai * HALF + m * 16) * 1024;
#pragma unroll
            for (int bj = 0; bj < 2; ++bj) { f32x4 v0, v1;
#pragma unroll
                for (int e = 0; e < 4; ++e) { v0[e] = fsig(acc[ai][bj][m][0][e]); v1[e] = fsig(acc[ai][bj][m][1][e]); }
                store8(rowp + bj * HALF, v0, v1); } }
    }
};
template <bool ADD> struct EpiGateAcc { static constexpr bool PERM = true, AFTER_DRAIN = false; const bf16_t* gate; bf16_t* O;
    __device__ __forceinline__ void operator()(const f32x4 (&acc)[2][2][4][2], const Unit& u, int wr, int wc, int fr, int fq) const {
        const int row0 = u.pm * BM + wr * 64 + fr, col0 = u.pn * 256 + wc * 32 + 8 * fq;
        EPI_FOR_ROWS { const size_t off = (size_t)(row0 + ai * HALF + m * 16) * 1024 + col0;
#pragma unroll
            for (int bj = 0; bj < 2; ++bj) { f32x4 g0, g1, v0, v1; load8(gate + off + bj * HALF, g0, g1); v0 = g0 * acc[ai][bj][m][0]; v1 = g1 * acc[ai][bj][m][1];
                if (ADD) { f32x4 t0, t1; load8(O + off + bj * HALF, t0, t1); v0 += t0; v1 += t1; }
                store8(O + off + bj * HALF, v0, v1); }
            asm volatile("" ::: "memory"); }
    }
};
struct EpiResid { static constexpr bool PERM = false, AFTER_DRAIN = false; const float* base; float* out; const float* gt; int gt_stride; float coef;
    __device__ __forceinline__ void operator()(const f32x4 (&acc)[2][2][4][2], const Unit& u, int wr, int wc, int fr, int fq) const {
        const int row0 = u.pm * BM + wr * 64 + fr, col0 = u.pn * BM + wc * 32 + 4 * fq; const float* gtp = gt + (size_t)(u.pm >> 5) * gt_stride + col0;
        f32x4 gv[2][2];
#pragma unroll
        for (int bj = 0; bj < 2; ++bj)
#pragma unroll
            for (int n = 0; n < 2; ++n) gv[bj][n] = *(const f32x4*)(gtp + bj * HALF + n * 16) * coef;
        EPI_FOR_ROWS { const size_t off = (size_t)(row0 + ai * HALF + m * 16) * 1024 + col0;
#pragma unroll
            for (int bj = 0; bj < 2; ++bj)
#pragma unroll
                for (int n = 0; n < 2; ++n) { const f32x4 bs = *(const f32x4*)(base + off + bj * HALF + n * 16); *(f32x4*)(out + off + bj * HALF + n * 16) = bs + gv[bj][n] * acc[ai][bj][m][n]; }
            asm volatile("" ::: "memory"); }
    }
};
#undef EPI_FOR_ROWS

template <class Epi, class Sched>
__device__ __forceinline__ void gemm_phase_naive(const Gemm g, const Sched& S, const Epi& E) {
    const int tid = threadIdx.x, wid = tid >> 6, lane = tid & 63, wr = wid >> 2, wc = wid & 3, fr = lane & 15, fq = lane >> 4;
    Unit cur;
    for (int ui = 0; S.next(ui, cur); ++ui) {
        f32x4 acc[2][2][4][2];
#pragma unroll
        for (int a = 0; a < 2; ++a)
#pragma unroll
            for (int b = 0; b < 2; ++b)
#pragma unroll
                for (int m = 0; m < 4; ++m)
#pragma unroll
                    for (int n = 0; n < 2; ++n) acc[a][b][m][n] = (f32x4){0.f, 0.f, 0.f, 0.f};
        const bf16_t* Ap = g.A + (size_t)(cur.pm * BM + wr * 64 + fr) * g.K;
        const bf16_t* Bp = g.Bt + (size_t)(cur.pn * BM + wc * 32 + (Epi::PERM ? 8 * fq : 4 * fq)) * g.K;
        for (int k = 0; k < g.K; ++k) {
            float av[2][4], bv[2][2][4];
#pragma unroll
            for (int a = 0; a < 2; ++a)
#pragma unroll
                for (int m = 0; m < 4; ++m) av[a][m] = __uint_as_float((unsigned)Ap[(size_t)(a * HALF + m * 16) * g.K + k] << 16);
#pragma unroll
            for (int b = 0; b < 2; ++b)
#pragma unroll
                for (int n = 0; n < 2; ++n)
#pragma unroll
                    for (int e = 0; e < 4; ++e) bv[b][n][e] = __uint_as_float((unsigned)Bp[(size_t)(b * HALF + (Epi::PERM ? 4 * n : 16 * n) + e) * g.K + k] << 16);
#pragma unroll
            for (int a = 0; a < 2; ++a)
#pragma unroll
                for (int b = 0; b < 2; ++b)
#pragma unroll
                    for (int m = 0; m < 4; ++m)
#pragma unroll
                        for (int n = 0; n < 2; ++n)
#pragma unroll
                            for (int e = 0; e < 4; ++e) acc[a][b][m][n][e] += av[a][m] * bv[b][n][e];
        }
        E(acc, cur, wr, wc, fr, fq);
    }
}
}
#ifndef NAIVE_GEMM
#define NAIVE_GEMM 0
#endif
#ifndef MK_PER_PHASE
#define MK_PER_PHASE 0
#endif
constexpr int NWAVES = 8;
constexpr int N_PHASES = 16;

constexpr int BATCH = 2, T = 8192, D = 1024, FF = 2816, NADA = 9216, CH = 128, NH = 8;
constexpr int M = BATCH * T;
constexpr int NMIXA = 5120, NMIXB = 2048, NMIX = NMIXA + NMIXB;
constexpr float EPS = 1e-6f;
enum { I_X = 0, I_C, I_WADA, I_BADA, I_GFFN1, I_W1IN, I_W1OUT, I_GMIX, I_WMIXIN, I_CONVW, I_LNG, I_LNB, I_WSP, I_BSP, I_WAOUT, I_WBOUT, I_WMIXOUT, I_GFFN2, I_W2IN, I_W2OUT, I_GFINAL, N_IN };

constexpr size_t MiB = 1u << 20;
constexpr size_t WS_CTL = 0, CTL_ZERO_BYTES = 64 * 1024;
constexpr size_t WS_ADAP = 1 * MiB;
constexpr size_t WS_ADA = 3 * MiB;
constexpr size_t WS_VST = 4 * MiB;
constexpr size_t WS_WSP = 6 * MiB;
constexpr size_t WS_W1IN = 8 * MiB, WS_W1OUT = 19 * MiB, WS_WMIX = 25 * MiB, WS_WA = 39 * MiB, WS_WB = 41 * MiB, WS_WO = 43 * MiB, WS_W2IN = 45 * MiB, WS_W2OUT = 56 * MiB;
constexpr size_t WS_H = 62 * MiB;
constexpr size_t WS_ACT = 94 * MiB;
constexpr size_t WS_END = WS_ACT + 128 * MiB;
static_assert(WS_W1IN + (size_t)2 * FF * D * 2 <= WS_W1OUT && WS_W1OUT + (size_t)D * FF * 2 <= WS_WMIX && WS_WMIX + (size_t)NMIX * D * 2 <= WS_WA && WS_W2IN + (size_t)2 * FF * D * 2 <= WS_W2OUT && WS_W2OUT + (size_t)D * FF * 2 <= WS_H, "d_ws map");
static_assert(WS_ADAP + (size_t)16 * 2 * NADA * 4 <= WS_ADA && WS_VST + (size_t)M * 32 * 4 <= WS_WSP && WS_END <= 256 * MiB, "d_ws map");
constexpr int CW_BAR = 1024;

constexpr int RING_OFF = 0, RING_BYTES = 131072;
constexpr int LDSCTL_OFF = RING_BYTES, MISC_OFF = LDSCTL_OFF + 320;
constexpr int LDS_BYTES = 147456;
#define GAS __attribute__((address_space(1)))
#define LAS __attribute__((address_space(3)))
typedef unsigned short bf16;
typedef unsigned v4u __attribute__((ext_vector_type(4)));
typedef float f32x4 __attribute__((ext_vector_type(4)));
typedef short bf16x8 __attribute__((ext_vector_type(8)));
typedef GAS unsigned gu32;
typedef GAS unsigned long long gu64;
#define RLX_AGENT __ATOMIC_RELAXED, __HIP_MEMORY_SCOPE_AGENT
#define LDS_WAIT() asm volatile("s_waitcnt lgkmcnt(0)" ::: "memory")
#define VM_WAIT() asm volatile("s_waitcnt vmcnt(0)" ::: "memory")
__device__ __forceinline__ unsigned long long rt() { return __builtin_amdgcn_s_memrealtime(); }
__device__ __forceinline__ unsigned f2bf(float f) { unsigned u = __builtin_bit_cast(unsigned, f); return (u + 0x7fffu + ((u >> 16) & 1u)) >> 16; }
__device__ __forceinline__ unsigned pk2(float lo, float hi) { return pg8::cvt_pk_bf16(lo, hi); }
#define XB_TMO      128
#define XB_XCNT(j)  (256  + 64 * (j))
#define XB_XSUB(j)  (1280 + 64 * (j))
#define XB_XGEN(j)  (2304 + 64 * (j))
#define XB_TOP      3328
#define XB_TOPGEN   3392
#define XCD_BAR_WORDS 3456
#define XB_SPIN_CAP (1u << 18)

__device__ __forceinline__ unsigned xb_ld(unsigned* p)              { return __hip_atomic_load(p, __ATOMIC_RELAXED, __HIP_MEMORY_SCOPE_AGENT); }
__device__ __forceinline__ unsigned xb_add(unsigned* p, unsigned v) { return __hip_atomic_fetch_add(p, v, __ATOMIC_RELAXED, __HIP_MEMORY_SCOPE_AGENT); }
__device__ __forceinline__ unsigned xb_xcc_id() { return (unsigned)__builtin_amdgcn_s_getreg((3 << 11) | 20) & 0xFu; }
#define XB_SPIN(cond, bar) do { unsigned _sp = 0; while (cond) { __builtin_amdgcn_s_sleep(1); \
    if ((++_sp & 255u) == 0u) { if (xb_ld(&(bar)[XB_TMO])) break; if (_sp > XB_SPIN_CAP) { atomicAdd(&(bar)[XB_TMO], 1u); break; } } } } while (0)

struct XcdBarrier {
    unsigned* bar; unsigned x;
    volatile LAS unsigned* st;
};

__device__ __forceinline__ XcdBarrier xcd_barrier_post(unsigned* bar, volatile LAS unsigned* st) {
    XcdBarrier b; b.bar = bar; b.x = xb_xcc_id(); b.st = st;
    if (threadIdx.x == 0) (void)xb_add(&bar[XB_XCNT(b.x)], 1u);
    return b;
}
__device__ __forceinline__ void xcd_barrier_complete(unsigned* bar, unsigned x, unsigned& nloc, unsigned& nx) {
    const unsigned G = gridDim.x * gridDim.y * gridDim.z;
    unsigned sum, cnt, mine, sp = 0u;
    for (;;) {
        sum = 0u; cnt = 0u; mine = 0u;
#pragma unroll
        for (unsigned j = 0; j < 16; ++j) { const unsigned c = xb_ld(&bar[XB_XCNT(j)]); sum += c; cnt += (c > 0u) ? 1u : 0u; mine = (j == x) ? c : mine; }
        if (sum == G) break;
        __builtin_amdgcn_s_sleep(1);
        if ((++sp & 255u) == 0u) { if (xb_ld(&bar[XB_TMO])) break; if (sp > XB_SPIN_CAP) { atomicAdd(&bar[XB_TMO], 1u); break; } }
    }
    nloc = mine > 0u ? mine : 1u; nx = cnt > 0u ? cnt : 1u;
}

__device__ __forceinline__ void xcd_barrier(const XcdBarrier& b) {
    asm volatile("s_waitcnt vmcnt(0)" ::: "memory");
    __syncthreads();
    if (threadIdx.x == 0) {
        unsigned* bar = b.bar;
        __builtin_amdgcn_s_waitcnt(0);
        unsigned nloc = b.st[0], nx = b.st[1];
        if (nloc == 0u) { xcd_barrier_complete(bar, b.x, nloc, nx); b.st[0] = nloc; b.st[1] = nx; }
        const unsigned old = xb_add(&bar[XB_XSUB(b.x)], 1u);
        const unsigned gen = old / nloc;
        if (old + 1u == (gen + 1u) * nloc) {
            __builtin_amdgcn_fence(__ATOMIC_RELEASE, "agent");
            asm volatile("s_waitcnt vmcnt(0)" ::: "memory");
            const unsigned og = xb_add(&bar[XB_TOP], 1u);
            const unsigned tg = og / nx;
            if (og + 1u == (tg + 1u) * nx) xb_add(&bar[XB_TOPGEN], 1u);
            else XB_SPIN(xb_ld(&bar[XB_TOPGEN]) == tg, bar);
            __builtin_amdgcn_fence(__ATOMIC_ACQUIRE, "agent");
            xb_add(&bar[XB_XGEN(b.x)], 1u);
            asm volatile("s_waitcnt vmcnt(0)" ::: "memory");
        } else {
            XB_SPIN(xb_ld(&bar[XB_XGEN(b.x)]) == gen, bar);
            __builtin_amdgcn_fence(__ATOMIC_ACQUIRE, "agent");
            asm volatile("s_waitcnt vmcnt(0)" ::: "memory");
        }
    }
    __syncthreads();
}
struct Frame {
    LAS unsigned char* lds;
    volatile LAS unsigned* MISC;
    gu32* ctl;
    int tid, lane, wave;
    int vcu, G;
};
__device__ __forceinline__ float wave_sum(float v) {
#pragma unroll
    for (int o = 1; o < 64; o <<= 1) v += __shfl_xor(v, o);
    return v;
}
__device__ __forceinline__ int dest_row(int mode, int n0) {
    if (mode == 1) { const int half = n0 / FF, j = n0 % FF; return 256 * (j / 128) + 128 * half + (j % 128); }
    if (mode == 2) { const int s = n0 / 1024, j = n0 % 1024;
        switch (s) { case 0: return NMIXA + j; case 1: return NMIXA + 1024 + j; case 2: return j; case 3: return 1024 + 256 * (j / 128) + (j % 128);
                     case 4: return 1024 + 256 * (j / 128) + 128 + (j % 128); case 5: return 3072 + j; default: return 4096 + j; } }
    return n0;
}
__device__ __forceinline__ void p0_transpose_item(const float* W, int K, int N, bf16* WT, int mode, LAS float* scr, int item, int lane) {
    const int nblk = N / 32, kb = item / nblk, nb = item % nblk, k0 = 64 * kb, n0 = 32 * nb, r0 = dest_row(mode, n0);
#pragma unroll 8
    for (int i = 0; i < 32; ++i) { const int kk = 2 * i + (lane >> 5); scr[kk * 33 + (lane & 31)] = W[(size_t)(k0 + kk) * N + n0 + (lane & 31)]; }
    LDS_WAIT(); asm volatile("" ::: "memory");
    const int c = lane & 7;
#pragma unroll
    for (int j = 0; j < 4; ++j) { const int n = (lane >> 3) + 8 * j; const LAS float* s = scr + (8 * c) * 33 + n;
        v4u o; o.x = pk2(s[0 * 33], s[1 * 33]); o.y = pk2(s[2 * 33], s[3 * 33]); o.z = pk2(s[4 * 33], s[5 * 33]); o.w = pk2(s[6 * 33], s[7 * 33]);
        *(GAS v4u*)(WT + (size_t)(r0 + n) * K + k0 + 8 * c) = o; }
    LDS_WAIT(); asm volatile("" ::: "memory");
}
struct Args { const float* in[N_IN]; float* out; unsigned char* ws; int ph_lo, ph_hi, li, pad; };

__device__ __forceinline__ void p0_prologue(Frame& F, const Args& A) {
    LAS float* scr = (LAS float*)(F.lds + RING_OFF + F.wave * 16384);
    const int gw = F.vcu * NWAVES + F.wave, NGW = F.G * NWAVES;
    unsigned char* ws = A.ws;
    constexpr int I_IN = (D / 64) * (2 * FF / 32), I_OUT = (FF / 64) * (D / 32), I_MIX = (D / 64) * ((NMIX) / 32), I_SQ = (D / 64) * (D / 32);
    constexpr int I_ADA = (NADA / 64) * 16, I_SP = NH * CH;
    constexpr int NITEMS = 2 * I_IN + 2 * I_OUT + I_MIX + 3 * I_SQ + I_ADA + I_SP;
    for (int it = gw; it < NITEMS; it += NGW) {
        int r = it;
        if (r < I_ADA) {
            const int nb = r / 16, kc = r % 16, n = 64 * nb + F.lane;
            const float c0 = A.in[I_C][64 * kc + F.lane], c1 = A.in[I_C][D + 64 * kc + F.lane];
            const float s0v = pg8::fsilu(c0), s1v = pg8::fsilu(c1);
            const float* wp = A.in[I_WADA] + (size_t)(64 * kc) * NADA + n; float a0 = 0.f, a1 = 0.f;
#pragma unroll 16
            for (int kk = 0; kk < 64; ++kk) { const float w = wp[(size_t)kk * NADA]; a0 += __shfl(s0v, kk) * w; a1 += __shfl(s1v, kk) * w; }
            float* ap = (float*)(ws + WS_ADAP); ap[(size_t)(kc * 2 + 0) * NADA + n] = a0; ap[(size_t)(kc * 2 + 1) * NADA + n] = a1; continue; } r -= I_ADA;
        if (r < I_IN) { p0_transpose_item(A.in[I_W1IN], D, 2 * FF, (bf16*)(ws + WS_W1IN), 1, scr, r, F.lane); continue; } r -= I_IN;
        if (r < I_OUT) { p0_transpose_item(A.in[I_W1OUT], FF, D, (bf16*)(ws + WS_W1OUT), 0, scr, r, F.lane); continue; } r -= I_OUT;
        if (r < I_MIX) { p0_transpose_item(A.in[I_WMIXIN], D, NMIX, (bf16*)(ws + WS_WMIX), 2, scr, r, F.lane); continue; } r -= I_MIX;
        if (r < I_SQ) { p0_transpose_item(A.in[I_WAOUT], D, D, (bf16*)(ws + WS_WA), 0, scr, r, F.lane); continue; } r -= I_SQ;
        if (r < I_SQ) { p0_transpose_item(A.in[I_WBOUT], D, D, (bf16*)(ws + WS_WB), 0, scr, r, F.lane); continue; } r -= I_SQ;
        if (r < I_SQ) { p0_transpose_item(A.in[I_WMIXOUT], D, D, (bf16*)(ws + WS_WO), 0, scr, r, F.lane); continue; } r -= I_SQ;
        if (r < I_IN) { p0_transpose_item(A.in[I_W2IN], D, 2 * FF, (bf16*)(ws + WS_W2IN), 1, scr, r, F.lane); continue; } r -= I_IN;
        if (r < I_OUT) { p0_transpose_item(A.in[I_W2OUT], FF, D, (bf16*)(ws + WS_W2OUT), 0, scr, r, F.lane); continue; } r -= I_OUT;
        {
            const int t = r % CH; const float* wp = A.in[I_WSP] + (size_t)r * CH + 2 * F.lane; const float w0 = wp[0], w1 = wp[1];
            ((unsigned*)(ws + WS_WSP))[(size_t)r * (CH / 2) + F.lane] = pk2(2 * F.lane <= t ? w0 : 0.f, 2 * F.lane + 1 <= t ? w1 : 0.f); }
    }
}
__device__ __forceinline__ void p1_ada_final(Frame& F, const Args& A) {
    const int gt = F.vcu * NWAVES * 64 + F.tid;
    if (gt < 2 * NADA) { const int b = gt / NADA, n = gt % NADA; const float* ap = (const float*)(A.ws + WS_ADAP); float s = A.in[I_BADA][n];
#pragma unroll
        for (int kc = 0; kc < 16; ++kc) s += ap[(size_t)(kc * 2 + b) * NADA + n];
        ((float*)(A.ws + WS_ADA))[gt] = s; }
}
__device__ __forceinline__ void norm_mod_phase(Frame& F, const float* src, const float* g, const float* ada, int sh_off, int sc_off, bf16* dst) {
    const int gw = F.vcu * NWAVES + F.wave, NGW = F.G * NWAVES;
    for (int b = 0; b < BATCH; ++b) {
        f32x4 gm[4], sh[4];
#pragma unroll
        for (int j = 0; j < 4; ++j) { const int c = 4 * F.lane + 256 * j; const f32x4 gg = *(const f32x4*)(g + c), sc = *(const f32x4*)(ada + (size_t)b * NADA + sc_off + c);
            gm[j] = gg * (sc + 1.0f); sh[j] = *(const f32x4*)(ada + (size_t)b * NADA + sh_off + c); }
        for (int r = gw; r < T; r += NGW) { const size_t m = (size_t)b * T + r;
            const GAS f32x4* xr = (const GAS f32x4*)(src + m * D) + F.lane; f32x4 v[4]; float s = 0.f;
#pragma unroll
            for (int j = 0; j < 4; ++j) { v[j] = xr[64 * j]; s += (v[j].x * v[j].x + v[j].y * v[j].y) + (v[j].z * v[j].z + v[j].w * v[j].w); }
            const float rstd = 1.f / sqrtf(wave_sum(s) * (1.f / D) + EPS);
            GAS unsigned long long* o8 = (GAS unsigned long long*)(dst + m * D) + F.lane;
#pragma unroll
            for (int j = 0; j < 4; ++j) { const f32x4 o = v[j] * rstd * gm[j] + sh[j]; o8[64 * j] = (unsigned long long)pk2(o.x, o.y) | ((unsigned long long)pk2(o.z, o.w) << 32); }
        }
    }
}
__device__ __forceinline__ void final_norm_phase(Frame& F, const float* src, const float* g, float* dst) {
    const int gw = F.vcu * NWAVES + F.wave, NGW = F.G * NWAVES;
    f32x4 gg[4];
#pragma unroll
    for (int j = 0; j < 4; ++j) gg[j] = *(const f32x4*)(g + 4 * F.lane + 256 * j);
    for (int m = gw; m < M; m += NGW) {
        const GAS f32x4* xr = (const GAS f32x4*)(src + (size_t)m * D) + F.lane; f32x4 v[4]; float s = 0.f;
#pragma unroll
        for (int j = 0; j < 4; ++j) { v[j] = xr[64 * j]; s += (v[j].x * v[j].x + v[j].y * v[j].y) + (v[j].z * v[j].z + v[j].w * v[j].w); }
        const float rstd = 1.f / sqrtf(wave_sum(s) * (1.f / D) + EPS);
        GAS f32x4* o = (GAS f32x4*)(dst + (size_t)m * D) + F.lane;
#pragma unroll
        for (int j = 0; j < 4; ++j) o[64 * j] = v[j] * rstd * gg[j];
    }
}
__device__ __forceinline__ void mix_phase(Frame& F, const Args& A) {
    constexpr int LTS = 136;
    LAS bf16* LT = (LAS bf16*)(F.lds + RING_OFF);
    LAS float* ST = (LAS float*)(F.lds + RING_OFF + 36864);
    bf16* BA = (bf16*)(A.ws + WS_ACT); bf16* Z = BA + (size_t)M * D; bf16* U = Z + (size_t)M * D; bf16* GV = U + (size_t)M * D;
    const float* vst = (const float*)(A.ws + WS_VST); const bf16* wsp = (const bf16*)(A.ws + WS_WSP);
    const int cg = F.tid & 15, tr = F.tid >> 4, fr = F.lane & 15, fq = F.lane >> 4, w = F.wave;
    for (int un = blockIdx.x; un < BATCH * (T / CH) * NH; un += F.G) {
        const int h = un % NH, n = (un / NH) % (T / CH), b = un / (NH * (T / CH));
        const size_t R0 = (size_t)b * T + (size_t)n * CH; const int C0 = h * CH;
        if (F.tid < CH) { const float* p = vst + (R0 + F.tid) * 32; float s = 0.f, q = 0.f;
#pragma unroll
            for (int i = 0; i < 16; ++i) { s += p[2 * i]; q += p[2 * i + 1]; }
            const float mean = s * (1.f / D), var = q * (1.f / D) - mean * mean; ST[2 * F.tid] = mean; ST[2 * F.tid + 1] = 1.f / sqrtf(var + EPS); }
        __syncthreads();
        {
            float lg[8], lb[8];
#pragma unroll
            for (int e = 0; e < 8; ++e) { lg[e] = A.in[I_LNG][C0 + cg * 8 + e]; lb[e] = A.in[I_LNB][C0 + cg * 8 + e]; }
#pragma unroll
            for (int i = 0; i < 4; ++i) { const int s = tr + 32 * i; f32x4 v0, v1; pg8::load8(GV + (R0 + s) * D + C0 + cg * 8, v0, v1); const float mean = ST[2 * s], rstd = ST[2 * s + 1];
#pragma unroll
                for (int e = 0; e < 4; ++e) { LT[(cg * 8 + e) * LTS + s] = (bf16)f2bf((v0[e] - mean) * rstd * lg[e] + lb[e]); LT[(cg * 8 + 4 + e) * LTS + s] = (bf16)f2bf((v1[e] - mean) * rstd * lg[4 + e] + lb[4 + e]); } }
        }
        __syncthreads();
        {
            f32x4 acc[8];
#pragma unroll
            for (int cb = 0; cb < 8; ++cb) acc[cb] = (f32x4){0.f, 0.f, 0.f, 0.f};
            const bf16* wrow = wsp + ((size_t)h * CH + 16 * w + fr) * CH + 8 * fq;
            const int nk = (16 * w + 15) / 32 + 1;
            for (int kk = 0; kk < nk; ++kk) { const bf16x8 y = *(const bf16x8*)(wrow + 32 * kk);
#pragma unroll
                for (int cb = 0; cb < 8; ++cb) { const bf16x8 x = *(const LAS bf16x8*)(LT + (16 * cb + fr) * LTS + 32 * kk + 8 * fq); acc[cb] = __builtin_amdgcn_mfma_f32_16x16x32_bf16(x, y, acc[cb], 0, 0, 0); } }
            const int t = 16 * w + fr; const float bias = A.in[I_BSP][h * CH + t]; bf16* up = U + (R0 + t) * D + C0 + 4 * fq;
#pragma unroll
            for (int cb = 0; cb < 8; ++cb) { const unsigned long long uw = *(const unsigned long long*)(up + 16 * cb); const unsigned lo = (unsigned)uw, hi = (unsigned)(uw >> 32);
                const float u0 = __uint_as_float(lo << 16), u1 = __uint_as_float(lo & 0xffff0000u), u2 = __uint_as_float(hi << 16), u3 = __uint_as_float(hi & 0xffff0000u);
                const f32x4 sv = acc[cb] + bias;
                *(unsigned long long*)(up + 16 * cb) = (unsigned long long)pk2(u0 * sv[0], u1 * sv[1]) | ((unsigned long long)pk2(u2 * sv[2], u3 * sv[3]) << 32); }
        }
        {
            float w0[8], w1[8], w2[8];
#pragma unroll
            for (int e = 0; e < 8; ++e) { w0[e] = A.in[I_CONVW][C0 + cg * 8 + e]; w1[e] = A.in[I_CONVW][D + C0 + cg * 8 + e]; w2[e] = A.in[I_CONVW][2 * D + C0 + cg * 8 + e]; }
            const int t0 = 4 * tr; const size_t cofs = (size_t)C0 + cg * 8;
            f32x4 za[2], zb[2];
            if (n == 0 && t0 == 0) { za[0] = za[1] = zb[0] = zb[1] = (f32x4){0.f, 0.f, 0.f, 0.f}; }
            else { pg8::load8(Z + (R0 + t0 - 2) * D + cofs, za[0], za[1]); pg8::load8(Z + (R0 + t0 - 1) * D + cofs, zb[0], zb[1]); }
#pragma unroll
            for (int i = 0; i < 4; ++i) { f32x4 zc[2], ba[2]; pg8::load8(Z + (R0 + t0 + i) * D + cofs, zc[0], zc[1]); pg8::load8(BA + (R0 + t0 + i) * D + cofs, ba[0], ba[1]);
                f32x4 o[2];
#pragma unroll
                for (int hh = 0; hh < 2; ++hh)
#pragma unroll
                    for (int e = 0; e < 4; ++e) o[hh][e] = ba[hh][e] * (w0[4 * hh + e] * za[hh][e] + w1[4 * hh + e] * zb[hh][e] + w2[4 * hh + e] * zc[hh][e]);
                pg8::store8(BA + (R0 + t0 + i) * D + cofs, o[0], o[1]);
                za[0] = zb[0]; za[1] = zb[1]; zb[0] = zc[0]; zb[1] = zc[1]; }
        }
        __syncthreads();
    }
}


#ifndef NAIVE_MIX
#define NAIVE_MIX 0
#endif
__device__ __forceinline__ void mix_phase_naive(Frame& F, const Args& A) {
    LAS float* ST = (LAS float*)(F.lds + RING_OFF);
    bf16* BA = (bf16*)(A.ws + WS_ACT); bf16* Z = BA + (size_t)M * D; bf16* U = Z + (size_t)M * D; bf16* GV = U + (size_t)M * D;
    auto ld = [](const bf16* p) { return __uint_as_float((unsigned)(*p) << 16); };
    for (int un = blockIdx.x; un < BATCH * (T / CH) * NH; un += F.G) {
        const int h = un % NH, n = (un / NH) % (T / CH), b = un / (NH * (T / CH));
        const size_t R0 = (size_t)b * T + (size_t)n * CH; const int C0 = h * CH;
        if (F.tid < CH) { float s = 0.f, q = 0.f; for (int c = 0; c < D; ++c) { const float v = ld(GV + (R0 + F.tid) * D + c); s += v; q += v * v; }
            const float mean = s / D, var = q / D - mean * mean; ST[2 * F.tid] = mean; ST[2 * F.tid + 1] = 1.f / sqrtf(var + EPS); }
        __syncthreads();
        for (int e = F.tid; e < CH * CH; e += NWAVES * 64) { const int t = e / CH, c = e % CH;
            float sv = A.in[I_BSP][h * CH + t];
            for (int s = 0; s <= t; ++s) sv += A.in[I_WSP][((size_t)h * CH + t) * CH + s] * ((ld(GV + (R0 + s) * D + C0 + c) - ST[2 * s]) * ST[2 * s + 1] * A.in[I_LNG][C0 + c] + A.in[I_LNB][C0 + c]);
            const float u = ld(U + (R0 + t) * D + C0 + c);
            float cv = 0.f;
            for (int k = 0; k < 3; ++k) { const int tt = n * CH + t - 2 + k; if (tt >= 0) cv += A.in[I_CONVW][k * D + C0 + c] * ld(Z + ((size_t)b * T + tt) * D + C0 + c); }
            const float ba = ld(BA + (R0 + t) * D + C0 + c);
            U[(R0 + t) * D + C0 + c] = (bf16)f2bf(u * sv); BA[(R0 + t) * D + C0 + c] = (bf16)f2bf(ba * cv); }
        __syncthreads();
    }
}

__global__ void __launch_bounds__(NWAVES * 64, 2) fwd_kernel(Args args) {
    extern __shared__ __attribute__((aligned(16))) unsigned char lds[];
    Frame F;
    F.lds = (LAS unsigned char*)lds;
    F.MISC = (volatile LAS unsigned*)(F.lds + MISC_OFF);
    F.tid = threadIdx.x; F.lane = F.tid & 63; F.wave = __builtin_amdgcn_readfirstlane(F.tid >> 6);
    F.G = gridDim.x; { const int bx = blockIdx.x; F.vcu = (F.G % 8 == 0) ? (bx % 8) * (F.G / 8) + bx / 8 : bx; }
    unsigned char* ws = args.ws;
    F.ctl = (gu32*)(ws + WS_CTL);
    for (int u = F.tid; u < (LDS_BYTES - LDSCTL_OFF) / 4; u += NWAVES * 64) ((LAS unsigned*)(F.lds + LDSCTL_OFF))[u] = 0u;
    __syncthreads();
    XcdBarrier bar; bar.bar = (unsigned*)(F.ctl + CW_BAR); bar.x = 0; bar.st = nullptr;
    if (!MK_PER_PHASE) bar = xcd_barrier_post((unsigned*)(F.ctl + CW_BAR), F.MISC + 8);
    const int lo = args.ph_lo, hi = args.ph_hi;
#define IN(k) (lo <= (k) && (k) < hi)
#define SEAM(k) do { if (IN(k) && IN((k) + 1)) xcd_barrier(bar); } while (0)
    bf16* H = (bf16*)(ws + WS_H); bf16* HID = (bf16*)(ws + WS_ACT);
    bf16* BA = (bf16*)(ws + WS_ACT); bf16* Zb = BA + (size_t)M * D; bf16* Ub = Zb + (size_t)M * D; bf16* GVb = Ub + (size_t)M * D;
    const float* ada = (const float*)(ws + WS_ADA);
    float* xs = args.out;
#ifndef NAIVE_MASK
#define NAIVE_MASK 0
#endif
#define RUN_GEMM(ph, EPI, g, S, E) do { if ((NAIVE_MASK >> (ph)) & 1) pg8::gemm_phase_naive<EPI, pg8::StaticOrder>(g, S, E); else pg8::gemm_phase<EPI, pg8::StaticOrder, true, true>(F.lds + RING_OFF, g, S, E); } while (0)
    if (IN(0)) { p0_prologue(F, args); } SEAM(0);
    if (IN(1)) { p1_ada_final(F, args); } SEAM(1);
    if (IN(2)) { norm_mod_phase(F, args.in[I_X], args.in[I_GFFN1], ada, 0 * D, 1 * D, H); } SEAM(2);
    if (IN(3)) { pg8::Gemm g{H, (const bf16*)(ws + WS_W1IN), M, 2 * FF, D}; pg8::StaticOrder S; S.init(M, 2 * FF, F.G, (int)blockIdx.x);
        pg8::EpiSwiglu E{HID, FF}; RUN_GEMM(3, pg8::EpiSwiglu, g, S, E); } SEAM(3);
    if (IN(4)) { pg8::Gemm g{HID, (const bf16*)(ws + WS_W1OUT), M, D, FF}; pg8::StaticOrder S; S.init(M, D, F.G, (int)blockIdx.x);
        pg8::EpiResid E{args.in[I_X], xs, ada + 2 * D, NADA, 0.5f}; RUN_GEMM(4, pg8::EpiResid, g, S, E); } SEAM(4);
    if (IN(5)) { norm_mod_phase(F, xs, args.in[I_GMIX], ada, 3 * D, 4 * D, H); } SEAM(5);
    if (IN(6)) { pg8::Gemm g{H, (const bf16*)(ws + WS_WMIX), M, NMIXA, D}; pg8::StaticOrder S; S.init(M, NMIXA, F.G, (int)blockIdx.x);
        pg8::EpiMixA E{BA, Zb, Ub, GVb, (float*)(ws + WS_VST)}; RUN_GEMM(6, pg8::EpiMixA, g, S, E); } SEAM(6);
    if (IN(7)) {
#if NAIVE_MIX
        mix_phase_naive(F, args);
#else
        mix_phase(F, args);
#endif
    } SEAM(7);
    if (IN(8)) { pg8::Gemm g{H, (const bf16*)(ws + WS_WMIX) + (size_t)NMIXA * D, M, NMIXB, D}; pg8::StaticOrder S; S.init(M, NMIXB, F.G, (int)blockIdx.x);
        pg8::EpiGates E{Zb, GVb}; RUN_GEMM(8, pg8::EpiGates, g, S, E); } SEAM(8);
    if (IN(9)) { pg8::Gemm g{BA, (const bf16*)(ws + WS_WA), M, D, D}; pg8::StaticOrder S; S.init(M, D, F.G, (int)blockIdx.x);
        pg8::EpiGateAcc<false> E{Zb, H}; RUN_GEMM(9, pg8::EpiGateAcc<false>, g, S, E); } SEAM(9);
    if (IN(10)) { pg8::Gemm g{Ub, (const bf16*)(ws + WS_WB), M, D, D}; pg8::StaticOrder S; S.init(M, D, F.G, (int)blockIdx.x);
        pg8::EpiGateAcc<true> E{GVb, H}; RUN_GEMM(10, pg8::EpiGateAcc<true>, g, S, E); } SEAM(10);
    if (IN(11)) { pg8::Gemm g{H, (const bf16*)(ws + WS_WO), M, D, D}; pg8::StaticOrder S; S.init(M, D, F.G, (int)blockIdx.x);
        pg8::EpiResid E{xs, xs, ada + 5 * D, NADA, 1.0f}; RUN_GEMM(11, pg8::EpiResid, g, S, E); } SEAM(11);
    if (IN(12)) { norm_mod_phase(F, xs, args.in[I_GFFN2], ada, 6 * D, 7 * D, H); } SEAM(12);
    if (IN(13)) { pg8::Gemm g{H, (const bf16*)(ws + WS_W2IN), M, 2 * FF, D}; pg8::StaticOrder S; S.init(M, 2 * FF, F.G, (int)blockIdx.x);
        pg8::EpiSwiglu E{HID, FF}; RUN_GEMM(13, pg8::EpiSwiglu, g, S, E); } SEAM(13);
    if (IN(14)) { pg8::Gemm g{HID, (const bf16*)(ws + WS_W2OUT), M, D, FF}; pg8::StaticOrder S; S.init(M, D, F.G, (int)blockIdx.x);
        pg8::EpiResid E{xs, xs, ada + 8 * D, NADA, 0.5f}; RUN_GEMM(14, pg8::EpiResid, g, S, E); } SEAM(14);
    if (IN(15)) { final_norm_phase(F, xs, args.in[I_GFINAL], xs); }
#undef IN
#undef SEAM
}

extern "C" void kernel_launch(void* const* d_in, const int* in_sizes, int n_in, void* d_out, int out_size, void* d_ws, size_t ws_size, hipStream_t stream) {
    static int grid = 0;
    if (grid == 0) {
        if (n_in != N_IN || in_sizes[0] != M * D || out_size != M * D || ws_size < WS_END) { fprintf(stderr, "kernel_launch: unexpected shapes (n_in %d, in0 %d, out %d, ws %zu)\n", n_in, n_in > 0 ? in_sizes[0] : -1, out_size, ws_size); grid = -1; return; }
        int dev = 0, cus = 0, per_cu = 0;
        if (hipGetDevice(&dev) != hipSuccess || hipDeviceGetAttribute(&cus, hipDeviceAttributeMultiprocessorCount, dev) != hipSuccess) { grid = -1; return; }
        if (hipFuncSetAttribute((const void*)fwd_kernel, hipFuncAttributeMaxDynamicSharedMemorySize, LDS_BYTES) != hipSuccess) { fprintf(stderr, "kernel_launch: hipFuncSetAttribute failed\n"); grid = -1; return; }
        if (hipOccupancyMaxActiveBlocksPerMultiprocessor(&per_cu, (const void*)fwd_kernel, NWAVES * 64, LDS_BYTES) != hipSuccess || per_cu < 1) { fprintf(stderr, "kernel_launch: occupancy query reports %d workgroups per CU\n", per_cu); per_cu = 1; }
        (void)hipGetLastError();
        grid = cus;
    }
    if (grid < 0) return;
    (void)hipMemsetAsync((char*)d_ws + WS_CTL, 0, CTL_ZERO_BYTES, stream);
    Args a{};
    for (int i = 0; i < N_IN; ++i) a.in[i] = (const float*)d_in[i];
    a.out = (float*)d_out; a.ws = (unsigned char*)d_ws;
#if MK_PER_PHASE
    for (int p = 0; p < N_PHASES; ++p) { a.ph_lo = p; a.ph_hi = p + 1; a.li = p; hipLaunchKernelGGL(fwd_kernel, dim3(grid), dim3(NWAVES * 64), LDS_BYTES, stream, a); }
#else
    a.ph_lo = 0; a.ph_hi = N_PHASES; a.li = 0;
    hipLaunchKernelGGL(fwd_kernel, dim3(grid), dim3(NWAVES * 64), LDS_BYTES, stream, a);
#endif
}
```

```cpp
#include <hip/hip_runtime.h>
#include <cstdio>
#include <cstdint>
namespace pg8 {
#define PG8_LAS __attribute__((address_space(3)))
typedef unsigned short bf16_t;
typedef short bf16x8 __attribute__((ext_vector_type(8)));
typedef float f32x4 __attribute__((ext_vector_type(4)));
typedef unsigned u32x4 __attribute__((ext_vector_type(4)));
constexpr int BM = 256, BK = 64, HALF = 128, HTB = HALF * BK * 2  , STAGE_BYTES = 8 * HTB, NXCD = 8, WGM = 8;

__host__ __device__ __forceinline__ int lds_byte(int r, int c) { const int st = (r >> 4) * 2 + (c >> 5), rr = r & 15, cc = c & 31, ob = rr * 64 + cc * 2; return st * 1024 + (ob ^ (((ob >> 9) & 1) << 5)); }
__host__ __device__ __forceinline__ void stage_rc(int b, int& R, int& C) { const int st = b / 1024, sb = b % 1024, swz = sb ^ (((sb >> 9) & 1) << 5); R = (st >> 1) * 16 + swz / 64; C = (st & 1) * 32 + (swz % 64) / 2; }
__host__ __device__ __forceinline__ int perm32(int rho) { const int n = rho >> 4, i = rho & 15; return 8 * (i >> 2) + 4 * n + (i & 3); }

struct Unit { int pm, pn, sel; };
struct Gemm { const bf16_t* A; const bf16_t* Bt; int M, N, K; const bf16_t* A2 = nullptr; const bf16_t* Bt2 = nullptr; };

struct StaticOrder {
    int nM, nN, nwg, G, c;
    __host__ __device__ void init(int M, int N, int G_, int c_) { nM = M / BM; nN = N / BM; nwg = nM * nN; G = G_; c = c_; }
    __host__ __device__ bool next(int i, Unit& u) const {
        const long L = (long)i * G + c; if (L >= nwg) return false;
        int wgid = (int)L; { const int q = nwg / NXCD, r = nwg % NXCD, xcd = wgid % NXCD, off = wgid / NXCD; wgid = (xcd < r ? xcd * (q + 1) : r * (q + 1) + (xcd - r) * q) + off; }
        const int nig = WGM * nN, gid = wgid / nig, fm = gid * WGM, gsz = (nM - fm) < WGM ? (nM - fm) : WGM;
        u.pm = fm + ((wgid % nig) % gsz); u.pn = (wgid % nig) / gsz; u.sel = 0; return true;
    }
    __device__ __forceinline__ void a_ready(const Unit&) const {}
    __device__ __forceinline__ void done(const Unit&) const {}
};

struct DualOrder { StaticOrder base;
    __host__ __device__ bool next(int i, Unit& u) const { if (!base.next(i >> 1, u)) return false; u.sel = i & 1; return true; }
    __device__ __forceinline__ void a_ready(const Unit&) const {}
    __device__ __forceinline__ void done(const Unit&) const {}
};
typedef __bf16 bf16x2_hw __attribute__((ext_vector_type(2)));
typedef float f32x2_hw __attribute__((ext_vector_type(2)));
__device__ __forceinline__ unsigned cvt_pk_bf16(float lo, float hi) { const f32x2_hw f = {lo, hi}; return __builtin_bit_cast(unsigned, __builtin_convertvector(f, bf16x2_hw)); }
typedef float f32x2 __attribute__((ext_vector_type(2)));
template <class Epi, class Sched, bool ALIGN_EPI = false, bool SP2 = false>
__device__ __forceinline__ void gemm_phase(PG8_LAS unsigned char* lds, const Gemm g, const Sched S, const Epi E) {
    const int tid = threadIdx.x, wid = __builtin_amdgcn_readfirstlane(tid >> 6), lane = tid & 63, wr = wid >> 2, wc = wid & 3, fr = lane & 15, fq = lane >> 4;
    const int K = g.K, nt = K / BK;
    unsigned voffA[2], voffB[2];
#pragma unroll
    for (int i = 0; i < 2; ++i) { int R, C; stage_rc(tid * 16 + i * 8192, R, C); const int Rb = Epi::PERM ? ((R & ~31) + perm32(R & 31)) : R;
        voffA[i] = (unsigned)(R * K + C) * 2u; voffB[i] = (unsigned)(Rb * K + C) * 2u; }
    const size_t kstep = (size_t)(BK * 2);
    const size_t hstep = (size_t)HALF * K * 2;
    const size_t tstep = 2 * hstep;
    const unsigned ldsw = (unsigned)wid * 1024u;
    const int aoff = lds_byte(wr * 64 + fr, fq * 8), boff = lds_byte(wc * 32 + fr, fq * 8);
#define PG8_SA(b, h) (((b) * 2 + (h)) * HTB)
#define PG8_SB(b, h) ((4 + (b) * 2 + (h)) * HTB)
#define PG8_STAGE(bufoff, gbase, voff) do { _Pragma("unroll") for (int _i = 0; _i < 2; ++_i) \
        __builtin_amdgcn_global_load_lds((const unsigned*)((const char*)(gbase) + (voff)[_i]), (PG8_LAS unsigned*)(lds + (bufoff) + ldsw + _i * 8192), 16, 0, 0); } while (0)
#define PG8_LDA(dst, b, h) do { _Pragma("unroll") for (int m = 0; m < 4; ++m) _Pragma("unroll") for (int k = 0; k < 2; ++k) dst[m][k] = *(const PG8_LAS bf16x8*)(lds + PG8_SA(b, h) + aoff + m * 2048 + k * 1024); } while (0)
#define PG8_LDB(dst, b, h) do { _Pragma("unroll") for (int n = 0; n < 2; ++n) _Pragma("unroll") for (int k = 0; k < 2; ++k) dst[n][k] = *(const PG8_LAS bf16x8*)(lds + PG8_SB(b, h) + boff + n * 2048 + k * 1024); } while (0)
#define PG8_MMA(ai, bj, At, Bt) do { __builtin_amdgcn_s_setprio(1); _Pragma("unroll") for (int m = 0; m < 4; ++m) _Pragma("unroll") for (int n = 0; n < 2; ++n) _Pragma("unroll") for (int k = 0; k < 2; ++k) \
        acc[ai][bj][m][n] = __builtin_amdgcn_mfma_f32_16x16x32_bf16(Bt[n][k], At[m][k], acc[ai][bj][m][n], 0, 0, 0); __builtin_amdgcn_s_setprio(0); } while (0)
#define PG8_WAIT_V(n) asm volatile("s_waitcnt vmcnt(" #n ")" ::: "memory")
#define PG8_WAIT_L(n) asm volatile("s_waitcnt lgkmcnt(" #n ")" ::: "memory")
#define PG8_BAR __builtin_amdgcn_s_barrier()
#define PG8_SCHED __builtin_amdgcn_sched_barrier(0)
    Unit cur, nxt; int ui = 0;
    if (!S.next(0, cur)) return;
    f32x4 acc[2][2][4][2];
#pragma unroll
    for (int a = 0; a < 2; ++a)
#pragma unroll
        for (int b = 0; b < 2; ++b)
#pragma unroll
            for (int m = 0; m < 4; ++m)
#pragma unroll
                for (int n = 0; n < 2; ++n) acc[a][b][m][n] = (f32x4){0.f, 0.f, 0.f, 0.f};
    bf16x8 At[4][2], B0[2][2], B1[2][2];
    const char* cA = (const char*)(Epi::DUAL && cur.sel ? g.A2 : g.A) + (size_t)cur.pm * tstep; const char* cB = (const char*)(Epi::DUAL && cur.sel ? g.Bt2 : g.Bt) + (size_t)cur.pn * tstep;
    S.a_ready(cur);
    if constexpr (SP2) {
        PG8_STAGE(PG8_SB(0, 0), cB, voffB); PG8_STAGE(PG8_SB(0, 1), cB + hstep, voffB); PG8_STAGE(PG8_SA(0, 0), cA, voffA); PG8_STAGE(PG8_SA(0, 1), cA + hstep, voffA);
        if (wr == 1) PG8_BAR;
        PG8_WAIT_V(2); PG8_BAR;
        PG8_STAGE(PG8_SB(1, 0), cB + kstep, voffB); PG8_STAGE(PG8_SA(1, 0), cA + kstep, voffA); PG8_STAGE(PG8_SB(1, 1), cB + hstep + kstep, voffB);
        PG8_WAIT_V(6); PG8_BAR;
    } else {
        PG8_STAGE(PG8_SB(0, 0), cB, voffB); PG8_STAGE(PG8_SA(0, 0), cA, voffA); PG8_STAGE(PG8_SB(0, 1), cB + hstep, voffB); PG8_STAGE(PG8_SA(0, 1), cA + hstep, voffA);
        if (wr == 1) PG8_BAR;
        PG8_WAIT_V(4); PG8_BAR;
        PG8_STAGE(PG8_SB(1, 0), cB + kstep, voffB); PG8_STAGE(PG8_SA(1, 0), cA + kstep, voffA); PG8_STAGE(PG8_SB(1, 1), cB + hstep + kstep, voffB);
        PG8_WAIT_V(6); PG8_BAR;
    }
    for (;;) {
        const bool has_next = S.next(ui + 1, nxt);
        const char* nA = has_next ? (const char*)(Epi::DUAL && nxt.sel ? g.A2 : g.A) + (size_t)nxt.pm * tstep : cA; const char* nB = has_next ? (const char*)(Epi::DUAL && nxt.sel ? g.Bt2 : g.Bt) + (size_t)nxt.pn * tstep : cB;
        for (int t = 0; t < nt; t += 2) {
            const bool last = (t == nt - 2);
            const char* a1 = cA + (size_t)(t + 1) * kstep;
            const char* a2 = last ? nA : cA + (size_t)(t + 2) * kstep; const char* b2 = last ? nB : cB + (size_t)(t + 2) * kstep;
            const char* a3 = a2 + kstep; const char* b3 = b2 + kstep;
            if (last && has_next) S.a_ready(nxt);
            if constexpr (SP2) {
            PG8_LDB(B0, 0, 0); PG8_LDB(B1, 0, 1); PG8_SCHED; PG8_LDA(At, 0, 0); PG8_STAGE(PG8_SA(1, 1), a1 + hstep, voffA);
            PG8_WAIT_V(8); PG8_WAIT_L(0); PG8_BAR; PG8_MMA(0, 0, At, B0); PG8_MMA(0, 1, At, B1); PG8_BAR; PG8_SCHED;
            PG8_LDA(At, 0, 1); PG8_STAGE(PG8_SB(0, 0), b2, voffB); PG8_STAGE(PG8_SB(0, 1), b2 + hstep, voffB); PG8_STAGE(PG8_SA(0, 0), a2, voffA);
            PG8_WAIT_V(8); PG8_WAIT_L(0); PG8_BAR; PG8_MMA(1, 0, At, B0); PG8_MMA(1, 1, At, B1); PG8_BAR; PG8_SCHED;
            PG8_LDB(B0, 1, 0); PG8_LDB(B1, 1, 1); PG8_SCHED; PG8_LDA(At, 1, 0); PG8_STAGE(PG8_SA(0, 1), a2 + hstep, voffA);
            PG8_WAIT_V(8); PG8_WAIT_L(0); PG8_BAR; PG8_MMA(0, 0, At, B0); PG8_MMA(0, 1, At, B1); PG8_BAR; PG8_SCHED;
            PG8_LDA(At, 1, 1); PG8_STAGE(PG8_SB(1, 0), b3, voffB); PG8_STAGE(PG8_SB(1, 1), b3 + hstep, voffB); PG8_STAGE(PG8_SA(1, 0), a3, voffA);
            PG8_WAIT_V(8); PG8_WAIT_L(0); PG8_BAR; PG8_MMA(1, 0, At, B0); PG8_MMA(1, 1, At, B1); PG8_BAR; PG8_SCHED;
            } else {
            PG8_LDB(B0, 0, 0); PG8_SCHED; PG8_LDA(At, 0, 0); PG8_STAGE(PG8_SA(1, 1), a1 + hstep, voffA);
            PG8_WAIT_L(8); PG8_BAR; PG8_WAIT_L(0); PG8_MMA(0, 0, At, B0); PG8_BAR; PG8_SCHED;
            PG8_LDB(B1, 0, 1); PG8_STAGE(PG8_SB(0, 0), b2, voffB);
            PG8_BAR; PG8_WAIT_L(0); PG8_MMA(0, 1, At, B1); PG8_BAR;
            PG8_LDA(At, 0, 1); PG8_STAGE(PG8_SA(0, 0), a2, voffA);
            PG8_BAR; PG8_WAIT_L(0); PG8_MMA(1, 0, At, B0); PG8_BAR; PG8_SCHED;
            PG8_STAGE(PG8_SB(0, 1), b2 + hstep, voffB);
            PG8_WAIT_V(6); PG8_BAR; PG8_MMA(1, 1, At, B1); PG8_BAR;
            PG8_LDB(B0, 1, 0); PG8_SCHED; PG8_LDA(At, 1, 0); PG8_STAGE(PG8_SA(0, 1), a2 + hstep, voffA);
            PG8_WAIT_L(8); PG8_BAR; PG8_WAIT_L(0); PG8_MMA(0, 0, At, B0); PG8_BAR; PG8_SCHED;
            PG8_LDB(B1, 1, 1); PG8_STAGE(PG8_SB(1, 0), b3, voffB);
            PG8_BAR; PG8_WAIT_L(0); PG8_MMA(0, 1, At, B1); PG8_BAR;
            PG8_LDA(At, 1, 1); PG8_STAGE(PG8_SA(1, 0), a3, voffA);
            PG8_BAR; PG8_WAIT_L(0); PG8_MMA(1, 0, At, B0); PG8_BAR; PG8_SCHED;
            PG8_STAGE(PG8_SB(1, 1), b3 + hstep, voffB);
            PG8_WAIT_V(6); PG8_BAR; PG8_MMA(1, 1, At, B1); PG8_BAR;
            }
        }
        if constexpr (ALIGN_EPI) { if (wr == 0) PG8_BAR; }
        if constexpr (!Epi::AFTER_DRAIN) { E(acc, cur, wr, wc, fr, fq); S.done(cur); }
        if (!has_next) break;
        if (!(Epi::DUAL && cur.sel == 0))
#pragma unroll
        for (int a = 0; a < 2; ++a)
#pragma unroll
            for (int b = 0; b < 2; ++b)
#pragma unroll
                for (int m = 0; m < 4; ++m)
#pragma unroll
                    for (int n = 0; n < 2; ++n) acc[a][b][m][n] = (f32x4){0.f, 0.f, 0.f, 0.f};
        cur = nxt; cA = nA; cB = nB; ++ui;
        if constexpr (ALIGN_EPI) { if (wr == 1) PG8_BAR; }
    }
    PG8_WAIT_V(0);
    if constexpr (!ALIGN_EPI) { if (wr == 0) PG8_BAR; }
    PG8_BAR;
    if constexpr (Epi::AFTER_DRAIN) { E.fused(acc, cur, wr, wc, fr, fq, lds, wid, lane); S.done(cur); }
#undef PG8_SA
#undef PG8_SB
#undef PG8_STAGE
#undef PG8_LDA
#undef PG8_LDB
#undef PG8_MMA
#undef PG8_WAIT_V
#undef PG8_WAIT_L
#undef PG8_BAR
#undef PG8_SCHED
}
__device__ __forceinline__ float fsig(float x) { return __builtin_amdgcn_rcpf(1.0f + __builtin_amdgcn_exp2f(-1.44269504089f * x)); }
__device__ __forceinline__ float fsilu(float x) { return x * fsig(x); }
__device__ __forceinline__ float fgelu(float x) { const float u = 1.5957691216057308f * (x + 0.044715f * x * x * x); return x * fsig(u); }
__device__ __forceinline__ f32x4 vsig(const f32x4 x) { const f32x4 t = x * (-1.44269504089f); f32x4 e; e[0] = __builtin_amdgcn_exp2f(t[0]); e[1] = __builtin_amdgcn_exp2f(t[1]); e[2] = __builtin_amdgcn_exp2f(t[2]); e[3] = __builtin_amdgcn_exp2f(t[3]);
    const f32x4 d = e + 1.0f; f32x4 r; r[0] = __builtin_amdgcn_rcpf(d[0]); r[1] = __builtin_amdgcn_rcpf(d[1]); r[2] = __builtin_amdgcn_rcpf(d[2]); r[3] = __builtin_amdgcn_rcpf(d[3]); return r; }
__device__ __forceinline__ f32x4 vsilu(const f32x4 x) { return x * vsig(x); }
__device__ __forceinline__ f32x4 vgelu(const f32x4 x) { const f32x4 u = (x * x * 0.044715f + 1.0f) * x * 1.5957691216057308f; return x * vsig(u); }
__device__ __forceinline__ void store8(bf16_t* p, f32x4 a, f32x4 b) { u32x4 w; w.x = cvt_pk_bf16(a[0], a[1]); w.y = cvt_pk_bf16(a[2], a[3]); w.z = cvt_pk_bf16(b[0], b[1]); w.w = cvt_pk_bf16(b[2], b[3]);
#ifdef NT_STORES
    __builtin_nontemporal_store(w, (u32x4*)p);
#else
    *(u32x4*)p = w;
#endif
}
__device__ __forceinline__ void load8(const bf16_t* p, f32x4& a, f32x4& b) { const u32x4 w = *(const u32x4*)p;
    a[0] = __uint_as_float(w.x << 16); a[1] = __uint_as_float(w.x & 0xffff0000u); a[2] = __uint_as_float(w.y << 16); a[3] = __uint_as_float(w.y & 0xffff0000u);
    b[0] = __uint_as_float(w.z << 16); b[1] = __uint_as_float(w.z & 0xffff0000u); b[2] = __uint_as_float(w.w << 16); b[3] = __uint_as_float(w.w & 0xffff0000u); }
__device__ __forceinline__ void unpack8(const u32x4 w, f32x4& a, f32x4& b) {
    a[0] = __uint_as_float(w.x << 16); a[1] = __uint_as_float(w.x & 0xffff0000u); a[2] = __uint_as_float(w.y << 16); a[3] = __uint_as_float(w.y & 0xffff0000u);
    b[0] = __uint_as_float(w.z << 16); b[1] = __uint_as_float(w.z & 0xffff0000u); b[2] = __uint_as_float(w.w << 16); b[3] = __uint_as_float(w.w & 0xffff0000u); }
#define EPI_FOR_ROWS _Pragma("unroll") for (int ai = 0; ai < 2; ++ai) _Pragma("unroll") for (int m = 0; m < 4; ++m)

struct Affine { const float* ss; const float* bias;
    int ldb;
    __device__ __forceinline__ void apply(f32x4 (&acc)[2][2][4][2], const Unit& u, int wr, int wc, int fr, int fq, int pn_off) const {
        const int row0 = u.pm * BM + wr * 64 + fr; const float* bp = bias + (size_t)(u.pm >> 5) * ldb + (u.pn + pn_off) * BM + wc * 32 + 8 * fq;
        f32x4 bv[2][2];
#pragma unroll
        for (int bj = 0; bj < 2; ++bj)
#pragma unroll
            for (int n = 0; n < 2; ++n) bv[bj][n] = *(const f32x4*)(bp + bj * HALF + 4 * n);
#pragma unroll
        for (int ai = 0; ai < 2; ++ai)
#pragma unroll
            for (int m = 0; m < 4; ++m) { const float rstd = 1.0f / sqrtf(ss[row0 + ai * HALF + m * 16] * (1.0f / 1024.0f) + 1e-6f);
#pragma unroll
                for (int bj = 0; bj < 2; ++bj)
#pragma unroll
                    for (int n = 0; n < 2; ++n) acc[ai][bj][m][n] = acc[ai][bj][m][n] * rstd + bv[bj][n]; }
    }
};
struct EpiSwiglu { static constexpr bool PERM = true, AFTER_DRAIN = false, DUAL = false; bf16_t* O; int ldc;
    __device__ __forceinline__ void operator()(f32x4 (&acc)[2][2][4][2], const Unit& u, int wr, int wc, int fr, int fq) const {
        const int row0 = u.pm * BM + wr * 64 + fr, col0 = u.pn * HALF + wc * 32 + 8 * fq;
        EPI_FOR_ROWS { bf16_t* rowp = O + (size_t)(row0 + ai * HALF + m * 16) * ldc + col0; f32x4 v0, v1;
#pragma unroll
            for (int e = 0; e < 1; ++e) { v0 = vsilu(acc[ai][0][m][0]) * acc[ai][1][m][0]; v1 = vsilu(acc[ai][0][m][1]) * acc[ai][1][m][1]; }
            store8(rowp, v0, v1); }
    }
};
struct EpiMixA { static constexpr bool PERM = true, AFTER_DRAIN = false, DUAL = false; bf16_t *BA, *Z, *U, *GV; float* vst;
    __device__ __forceinline__ void operator()(f32x4 (&acc)[2][2][4][2], const Unit& u, int wr, int wc, int fr, int fq) const {
        const int row0 = u.pm * BM + wr * 64 + fr, pn = u.pn, cw = wc * 32 + 8 * fq;
        if (pn < 4) {
            EPI_FOR_ROWS { bf16_t* rowp = BA + (size_t)(row0 + ai * HALF + m * 16) * 1024 + pn * 256 + cw;
#pragma unroll
                for (int bj = 0; bj < 2; ++bj) store8(rowp + bj * HALF, acc[ai][bj][m][0], acc[ai][bj][m][1]); }
        } else if (pn < 12) {
            EPI_FOR_ROWS { bf16_t* rowp = Z + (size_t)(row0 + ai * HALF + m * 16) * 1024 + (pn - 4) * HALF + cw;
                store8(rowp, acc[ai][0][m][0] * acc[ai][1][m][0], acc[ai][0][m][1] * acc[ai][1][m][1]); }
        } else if (pn < 16) {
            EPI_FOR_ROWS { bf16_t* rowp = U + (size_t)(row0 + ai * HALF + m * 16) * 1024 + (pn - 12) * 256 + cw;
#pragma unroll
                for (int bj = 0; bj < 2; ++bj) { f32x4 v0, v1;
#pragma unroll
                    for (int e = 0; e < 1; ++e) { v0 = vgelu(acc[ai][bj][m][0]); v1 = vgelu(acc[ai][bj][m][1]); }
                    store8(rowp + bj * HALF, v0, v1); } }
        } else {
            EPI_FOR_ROWS { const int row = row0 + ai * HALF + m * 16; bf16_t* rowp = GV + (size_t)row * 1024 + (pn - 16) * 256 + cw; float s = 0.f, q = 0.f;
#pragma unroll
                for (int bj = 0; bj < 2; ++bj) { f32x4 v0, v1;
#pragma unroll
                    for (int e = 0; e < 1; ++e) { v0 = vgelu(acc[ai][bj][m][0]); v1 = vgelu(acc[ai][bj][m][1]); const f32x4 sv = v0 + v1, qv = v0 * v0 + v1 * v1; s += (sv[0] + sv[1]) + (sv[2] + sv[3]); q += (qv[0] + qv[1]) + (qv[2] + qv[3]); }
                    store8(rowp + bj * HALF, v0, v1); }
                s += __shfl_xor(s, 16); s += __shfl_xor(s, 32); q += __shfl_xor(q, 16); q += __shfl_xor(q, 32);
                if (fq == 0) *(f32x2*)(vst + ((size_t)row * 16 + (pn - 16) * 4 + wc) * 2) = (f32x2){s, q}; }
        }
    }
};
struct EpiGates { static constexpr bool PERM = true, AFTER_DRAIN = false, DUAL = false; bf16_t *SGA, *SGB;
    __device__ __forceinline__ void operator()(f32x4 (&acc)[2][2][4][2], const Unit& u, int wr, int wc, int fr, int fq) const {
        const int row0 = u.pm * BM + wr * 64 + fr, pn = u.pn; bf16_t* base = (pn < 4 ? SGA : SGB) + (pn & 3) * 256 + wc * 32 + 8 * fq;
        EPI_FOR_ROWS { bf16_t* rowp = base + (size_t)(row0 + ai * HALF + m * 16) * 1024;
#pragma unroll
            for (int bj = 0; bj < 2; ++bj) { f32x4 v0, v1;
#pragma unroll
                for (int e = 0; e < 1; ++e) { v0 = vsig(acc[ai][bj][m][0]); v1 = vsig(acc[ai][bj][m][1]); }
                store8(rowp + bj * HALF, v0, v1); } }
    }
};
template <bool ADD> struct EpiGateAcc { static constexpr bool PERM = true, AFTER_DRAIN = false, DUAL = false; const bf16_t* gate; bf16_t* O;
    __device__ __forceinline__ void operator()(const f32x4 (&acc)[2][2][4][2], const Unit& u, int wr, int wc, int fr, int fq) const {
        const int row0 = u.pm * BM + wr * 64 + fr, col0 = u.pn * 256 + wc * 32 + 8 * fq;
        EPI_FOR_ROWS { const size_t off = (size_t)(row0 + ai * HALF + m * 16) * 1024 + col0;
#pragma unroll
            for (int bj = 0; bj < 2; ++bj) { f32x4 g0, g1, v0, v1; load8(gate + off + bj * HALF, g0, g1); v0 = g0 * acc[ai][bj][m][0]; v1 = g1 * acc[ai][bj][m][1];
                if (ADD) { f32x4 t0, t1; load8(O + off + bj * HALF, t0, t1); v0 += t0; v1 += t1; }
                store8(O + off + bj * HALF, v0, v1); }
            asm volatile("" ::: "memory"); }
    }
};
struct EpiDualGate { static constexpr bool PERM = true, AFTER_DRAIN = false, DUAL = true; const bf16_t *sga, *sgb; bf16_t* O;
    __device__ __forceinline__ void operator()(f32x4 (&acc)[2][2][4][2], const Unit& u, int wr, int wc, int fr, int fq) const {
        const int row0 = u.pm * BM + wr * 64 + fr, col0 = u.pn * 256 + wc * 32 + 8 * fq;
        if (u.sel == 0) {
            EPI_FOR_ROWS { const size_t off = (size_t)(row0 + ai * HALF + m * 16) * 1024 + col0;
#pragma unroll
                for (int bj = 0; bj < 2; ++bj) { f32x4 a0, a1, b0, b1; load8(sga + off + bj * HALF, a0, a1); load8(sgb + off + bj * HALF, b0, b1);
#pragma unroll
                    for (int e = 0; e < 4; ++e) { acc[ai][bj][m][0][e] *= a0[e] * __builtin_amdgcn_rcpf(fmaxf(b0[e], 1e-30f)); acc[ai][bj][m][1][e] *= a1[e] * __builtin_amdgcn_rcpf(fmaxf(b1[e], 1e-30f)); } }
                asm volatile("" ::: "memory"); }
        } else {
            EPI_FOR_ROWS { const size_t off = (size_t)(row0 + ai * HALF + m * 16) * 1024 + col0;
#pragma unroll
                for (int bj = 0; bj < 2; ++bj) { f32x4 b0, b1, v0, v1; load8(sgb + off + bj * HALF, b0, b1);
#pragma unroll
                    for (int e = 0; e < 4; ++e) { v0[e] = acc[ai][bj][m][0][e] * fmaxf(b0[e], 1e-30f); v1[e] = acc[ai][bj][m][1][e] * fmaxf(b1[e], 1e-30f); }
                    store8(O + off + bj * HALF, v0, v1); }
                asm volatile("" ::: "memory"); }
        }
    }
};
template <int MODE, bool BASE16, bool OUT16> struct EpiResidNorm { static constexpr bool PERM = false, AFTER_DRAIN = true, DUAL = false;
    __device__ __forceinline__ static f32x4 ld4bf(const bf16_t* p) { const f32x2 w = __builtin_nontemporal_load((const f32x2*)p);     const unsigned lo = __float_as_uint(w.x), hi = __float_as_uint(w.y);
        return (f32x4){__uint_as_float(lo << 16), __uint_as_float(lo & 0xffff0000u), __uint_as_float(hi << 16), __uint_as_float(hi & 0xffff0000u)}; }
    __device__ __forceinline__ static void st8pair(bf16_t* rowp_n0, const f32x4 h0, const f32x4 h1, int fq) {
        const unsigned a0 = cvt_pk_bf16(h0[0], h0[1]), a1 = cvt_pk_bf16(h0[2], h0[3]), b0 = cvt_pk_bf16(h1[0], h1[1]), b1 = cvt_pk_bf16(h1[2], h1[3]); const bool odd = fq & 1;
        const unsigned rx = (unsigned)__shfl_xor((int)(odd ? a0 : b0), 16), ry = (unsigned)__shfl_xor((int)(odd ? a1 : b1), 16);
        u32x4 o; if (odd) { o.x = rx; o.y = ry; o.z = b0; o.w = b1; } else { o.x = a0; o.y = a1; o.z = rx; o.w = ry; }
        *(u32x4*)(rowp_n0 + (odd ? 12 : 0)) = o; }
    __device__ __forceinline__ static void ld8pair(const bf16_t* rowp_n0, f32x4& h0, f32x4& h1, int fq) {
        const bool odd = fq & 1; const u32x4 w = __builtin_nontemporal_load((const u32x4*)(rowp_n0 + (odd ? 12 : 0)));
        const unsigned rx = (unsigned)__shfl_xor((int)(odd ? w.x : w.z), 16), ry = (unsigned)__shfl_xor((int)(odd ? w.y : w.w), 16);
        const unsigned n0x = odd ? rx : w.x, n0y = odd ? ry : w.y, n1x = odd ? w.z : rx, n1y = odd ? w.w : ry;
        h0 = (f32x4){__uint_as_float(n0x << 16), __uint_as_float(n0x & 0xffff0000u), __uint_as_float(n0y << 16), __uint_as_float(n0y & 0xffff0000u)};
        h1 = (f32x4){__uint_as_float(n1x << 16), __uint_as_float(n1x & 0xffff0000u), __uint_as_float(n1y << 16), __uint_as_float(n1y & 0xffff0000u)}; }
    const void* base; void* out; const float* ada; int gt_off; float coef; const float* g; int sh_off, sc_off; bf16_t* xb; float* ss; unsigned* cnt;
    __device__ __forceinline__ void fused(f32x4 (&acc)[2][2][4][2], const Unit& u, int wr, int wc, int fr, int fq, PG8_LAS unsigned char* lds, int wid, int lane) const {
        const float* ada_ = ada; const float* g_ = g; float coef_ = coef; float* ss_ = ss;
        asm volatile("" : "+s"(ada_), "+s"(g_), "+s"(coef_), "+s"(ss_));
        const int row0 = u.pm * BM + wr * 64 + fr, col0 = u.pn * BM + wc * 32 + 4 * fq; const float* adb = ada_ + (size_t)(u.pm >> 5) * 9216 + col0;
        {   f32x4 gv[2][2];
#pragma unroll
            for (int bj = 0; bj < 2; ++bj)
#pragma unroll
                for (int n = 0; n < 2; ++n) gv[bj][n] = *(const f32x4*)(adb + gt_off + bj * HALF + n * 16) * coef_;
            EPI_FOR_ROWS { const int row = row0 + ai * HALF + m * 16; const size_t off = (size_t)row * 1024 + col0; float q = 0.f;
#pragma unroll
                for (int bj = 0; bj < 2; ++bj) { f32x4 bsv[2];
                    if (BASE16) ld8pair((const bf16_t*)base + off + bj * HALF, bsv[0], bsv[1], fq);
                    else { bsv[0] = __builtin_nontemporal_load((const f32x4*)((const float*)base + off + bj * HALF)); bsv[1] = __builtin_nontemporal_load((const f32x4*)((const float*)base + off + bj * HALF + 16)); }
#pragma unroll
                    for (int n = 0; n < 2; ++n) { const f32x4 o = bsv[n] + gv[bj][n] * acc[ai][bj][m][n]; acc[ai][bj][m][n] = o;
                        q += (o[0] * o[0] + o[1] * o[1]) + (o[2] * o[2] + o[3] * o[3]); } }
                q += __shfl_xor(q, 16); q += __shfl_xor(q, 32); if (fq == 0) atomicAdd(ss_ + row, q);
                asm volatile("" ::: "memory"); }
        }
        asm volatile("s_waitcnt vmcnt(0)" ::: "memory");
        unsigned* c = cnt + 64 * u.pm;
        if (lane == 0) __hip_atomic_fetch_add(c, 1u, __ATOMIC_RELAXED, __HIP_MEMORY_SCOPE_AGENT);
        if (MODE == 0) {
            EPI_FOR_ROWS { const size_t off = (size_t)(row0 + ai * HALF + m * 16) * 1024 + col0;
#pragma unroll
                for (int bj = 0; bj < 2; ++bj) {
                    if (OUT16) st8pair((bf16_t*)out + off + bj * HALF, acc[ai][bj][m][0], acc[ai][bj][m][1], fq);
                    else {
#pragma unroll
                        for (int n = 0; n < 2; ++n) *(f32x4*)((float*)out + off + bj * HALF + n * 16) = acc[ai][bj][m][n]; } } } }
        if (wid == 0) { unsigned spins = 0; while (__hip_atomic_load(c, __ATOMIC_RELAXED, __HIP_MEMORY_SCOPE_AGENT) < 32u) { __builtin_amdgcn_s_sleep(1); if (++spins > (1u << 20)) break; } }
        __builtin_amdgcn_s_barrier();
        asm volatile("" ::: "memory");
        float rstd[2][4];
        EPI_FOR_ROWS rstd[ai][m] = 1.0f / sqrtf(__hip_atomic_load(ss_ + row0 + ai * HALF + m * 16, __ATOMIC_RELAXED, __HIP_MEMORY_SCOPE_AGENT) * (1.0f / 1024.0f) + 1e-6f);
        f32x4 gm[2][2], sh[2][2];
#pragma unroll
        for (int bj = 0; bj < 2; ++bj)
#pragma unroll
            for (int n = 0; n < 2; ++n) { const int cc = bj * HALF + n * 16; gm[bj][n] = *(const f32x4*)(g_ + col0 + cc);
                if (MODE == 0) { gm[bj][n] = gm[bj][n] * (*(const f32x4*)(adb + sc_off + cc) + 1.0f); sh[bj][n] = *(const f32x4*)(adb + sh_off + cc); } }
        EPI_FOR_ROWS { const size_t off = (size_t)(row0 + ai * HALF + m * 16) * 1024 + col0; const float r = rstd[ai][m];
#pragma unroll
            for (int bj = 0; bj < 2; ++bj) {
                if (MODE == 0) st8pair(xb + off + bj * HALF, acc[ai][bj][m][0] * r * gm[bj][0] + sh[bj][0], acc[ai][bj][m][1] * r * gm[bj][1] + sh[bj][1], fq);
                else {
#pragma unroll
                    for (int n = 0; n < 2; ++n) *(f32x4*)((float*)out + off + bj * HALF + n * 16) = acc[ai][bj][m][n] * r * gm[bj][n]; } } }
    }
};
#undef EPI_FOR_ROWS

template <class Epi, class Sched>
__device__ __forceinline__ void gemm_phase_naive(const Gemm g, const Sched& S, const Epi& E) {
    const int tid = threadIdx.x, wid = tid >> 6, lane = tid & 63, wr = wid >> 2, wc = wid & 3, fr = lane & 15, fq = lane >> 4;
    Unit cur;
    for (int ui = 0; S.next(ui, cur); ++ui) {
        f32x4 acc[2][2][4][2];
#pragma unroll
        for (int a = 0; a < 2; ++a)
#pragma unroll
            for (int b = 0; b < 2; ++b)
#pragma unroll
                for (int m = 0; m < 4; ++m)
#pragma unroll
                    for (int n = 0; n < 2; ++n) acc[a][b][m][n] = (f32x4){0.f, 0.f, 0.f, 0.f};
        const bf16_t* Ap = g.A + (size_t)(cur.pm * BM + wr * 64 + fr) * g.K;
        const bf16_t* Bp = g.Bt + (size_t)(cur.pn * BM + wc * 32 + (Epi::PERM ? 8 * fq : 4 * fq)) * g.K;
        for (int k = 0; k < g.K; ++k) {
            float av[2][4], bv[2][2][4];
#pragma unroll
            for (int a = 0; a < 2; ++a)
#pragma unroll
                for (int m = 0; m < 4; ++m) av[a][m] = __uint_as_float((unsigned)Ap[(size_t)(a * HALF + m * 16) * g.K + k] << 16);
#pragma unroll
            for (int b = 0; b < 2; ++b)
#pragma unroll
                for (int n = 0; n < 2; ++n)
#pragma unroll
                    for (int e = 0; e < 4; ++e) bv[b][n][e] = __uint_as_float((unsigned)Bp[(size_t)(b * HALF + (Epi::PERM ? 4 * n : 16 * n) + e) * g.K + k] << 16);
#pragma unroll
            for (int a = 0; a < 2; ++a)
#pragma unroll
                for (int b = 0; b < 2; ++b)
#pragma unroll
                    for (int m = 0; m < 4; ++m)
#pragma unroll
                        for (int n = 0; n < 2; ++n)
#pragma unroll
                            for (int e = 0; e < 4; ++e) acc[a][b][m][n][e] += av[a][m] * bv[b][n][e];
        }
        if constexpr (Epi::AFTER_DRAIN) E.fused(acc, cur, wr, wc, fr, fq, (PG8_LAS unsigned char*)nullptr, wid, lane); else E(acc, cur, wr, wc, fr, fq);
    }
}
}
#ifndef NAIVE_GEMM
#define NAIVE_GEMM 0
#endif
#ifndef MK_PER_PHASE
#define MK_PER_PHASE 0
#endif
constexpr int NWAVES = 8;
constexpr int N_PHASES = 11;

constexpr int BATCH = 2, T = 8192, D = 1024, FF = 2816, NADA = 9216, CH = 128, NH = 8;
constexpr int M = BATCH * T;
constexpr int NMIXA = 5120, NMIXB = 2048, NMIX = NMIXA + NMIXB;
constexpr float EPS = 1e-6f;
enum { I_X = 0, I_C, I_WADA, I_BADA, I_GFFN1, I_W1IN, I_W1OUT, I_GMIX, I_WMIXIN, I_CONVW, I_LNG, I_LNB, I_WSP, I_BSP, I_WAOUT, I_WBOUT, I_WMIXOUT, I_GFFN2, I_W2IN, I_W2OUT, I_GFINAL, N_IN };

constexpr size_t MiB = 1u << 20;
constexpr size_t WS_CTL = 0, CTL_ZERO_BYTES = 512 * 1024;
constexpr size_t WS_SS = 256 * 1024;
constexpr size_t WS_ADAP = 222 * MiB;
constexpr size_t WS_ADA = 3 * MiB;
constexpr size_t WS_BIASW = 3 * MiB + 512 * 1024;
constexpr size_t WS_VST = 4 * MiB;
constexpr size_t WS_WSP = 6 * MiB;
constexpr size_t WS_W1IN = 8 * MiB, WS_W1OUT = 19 * MiB, WS_WMIX = 25 * MiB, WS_WA = 39 * MiB, WS_WB = 41 * MiB, WS_WO = 43 * MiB, WS_W2IN = 45 * MiB, WS_W2OUT = 56 * MiB;
constexpr size_t WS_H = 62 * MiB;
constexpr size_t WS_ACT = 94 * MiB;
constexpr size_t WS_G = 222 * MiB;
constexpr size_t WS_END = WS_G + 32 * MiB;
static_assert(WS_W1IN + (size_t)2 * FF * D * 2 <= WS_W1OUT && WS_W1OUT + (size_t)D * FF * 2 <= WS_WMIX && WS_WMIX + (size_t)NMIX * D * 2 <= WS_WA && WS_W2IN + (size_t)2 * FF * D * 2 <= WS_W2OUT && WS_W2OUT + (size_t)D * FF * 2 <= WS_H, "d_ws map");
static_assert(WS_ADAP + (size_t)32 * 2 * NADA * 4 <= WS_END && WS_VST + (size_t)M * 32 * 4 <= WS_WSP && WS_END <= 256 * MiB, "d_ws map");
constexpr int CW_BAR = 1024;
constexpr int CW_CNT = 16384;

constexpr int RING_OFF = 0, RING_BYTES = 131072;
constexpr int LDSCTL_OFF = RING_BYTES, MISC_OFF = LDSCTL_OFF + 320;
constexpr int LDS_BYTES = 147456;
#define GAS __attribute__((address_space(1)))
#define LAS __attribute__((address_space(3)))
typedef unsigned short bf16;
typedef unsigned v4u __attribute__((ext_vector_type(4)));
typedef float f32x4 __attribute__((ext_vector_type(4)));
typedef short bf16x8 __attribute__((ext_vector_type(8)));
typedef GAS unsigned gu32;
typedef GAS unsigned long long gu64;
#define RLX_AGENT __ATOMIC_RELAXED, __HIP_MEMORY_SCOPE_AGENT
#define LDS_WAIT() asm volatile("s_waitcnt lgkmcnt(0)" ::: "memory")
#define VM_WAIT() asm volatile("s_waitcnt vmcnt(0)" ::: "memory")
__device__ __forceinline__ unsigned long long rt() { return __builtin_amdgcn_s_memrealtime(); }
__device__ __forceinline__ unsigned f2bf(float f) { unsigned u = __builtin_bit_cast(unsigned, f); return (u + 0x7fffu + ((u >> 16) & 1u)) >> 16; }
__device__ __forceinline__ unsigned pk2(float lo, float hi) { return pg8::cvt_pk_bf16(lo, hi); }
#define XB_TMO      128
#define XB_XCNT(j)  (256  + 64 * (j))
#define XB_XSUB(j)  (1280 + 64 * (j))
#define XB_XGEN(j)  (2304 + 64 * (j))
#define XB_TOP      3328
#define XB_TOPGEN   3392
#define XCD_BAR_WORDS 3456
#define XB_SPIN_CAP (1u << 18)

__device__ __forceinline__ unsigned xb_ld(unsigned* p)              { return __hip_atomic_load(p, __ATOMIC_RELAXED, __HIP_MEMORY_SCOPE_AGENT); }
__device__ __forceinline__ unsigned xb_add(unsigned* p, unsigned v) { return __hip_atomic_fetch_add(p, v, __ATOMIC_RELAXED, __HIP_MEMORY_SCOPE_AGENT); }
__device__ __forceinline__ unsigned xb_xcc_id() { return (unsigned)__builtin_amdgcn_s_getreg((3 << 11) | 20) & 0xFu; }
#define XB_SPIN(cond, bar) do { unsigned _sp = 0; while (cond) { __builtin_amdgcn_s_sleep(1); \
    if ((++_sp & 255u) == 0u) { if (xb_ld(&(bar)[XB_TMO])) break; if (_sp > XB_SPIN_CAP) { atomicAdd(&(bar)[XB_TMO], 1u); break; } } } } while (0)

struct XcdBarrier {
    unsigned* bar; unsigned x;
    volatile LAS unsigned* st;
};

__device__ __forceinline__ XcdBarrier xcd_barrier_post(unsigned* bar, volatile LAS unsigned* st) {
    XcdBarrier b; b.bar = bar; b.x = xb_xcc_id(); b.st = st;
    if (threadIdx.x == 0) (void)xb_add(&bar[XB_XCNT(b.x)], 1u);
    return b;
}
__device__ __forceinline__ void xcd_barrier_complete(unsigned* bar, unsigned x, unsigned& nloc, unsigned& nx) {
    const unsigned G = gridDim.x * gridDim.y * gridDim.z;
    unsigned sum, cnt, mine, sp = 0u;
    for (;;) {
        sum = 0u; cnt = 0u; mine = 0u;
#pragma unroll
        for (unsigned j = 0; j < 16; ++j) { const unsigned c = xb_ld(&bar[XB_XCNT(j)]); sum += c; cnt += (c > 0u) ? 1u : 0u; mine = (j == x) ? c : mine; }
        if (sum == G) break;
        __builtin_amdgcn_s_sleep(1);
        if ((++sp & 255u) == 0u) { if (xb_ld(&bar[XB_TMO])) break; if (sp > XB_SPIN_CAP) { atomicAdd(&bar[XB_TMO], 1u); break; } }
    }
    nloc = mine > 0u ? mine : 1u; nx = cnt > 0u ? cnt : 1u;
}

__device__ __forceinline__ void xcd_barrier(const XcdBarrier& b) {
    asm volatile("s_waitcnt vmcnt(0)" ::: "memory");
    __syncthreads();
    if (threadIdx.x == 0) {
        unsigned* bar = b.bar;
        __builtin_amdgcn_s_waitcnt(0);
        unsigned nloc = b.st[0], nx = b.st[1];
        if (nloc == 0u) { xcd_barrier_complete(bar, b.x, nloc, nx); b.st[0] = nloc; b.st[1] = nx; }
        const unsigned old = xb_add(&bar[XB_XSUB(b.x)], 1u);
        const unsigned gen = old / nloc;
        if (old + 1u == (gen + 1u) * nloc) {
            __builtin_amdgcn_fence(__ATOMIC_RELEASE, "agent");
            asm volatile("s_waitcnt vmcnt(0)" ::: "memory");
            const unsigned og = xb_add(&bar[XB_TOP], 1u);
            const unsigned tg = og / nx;
            if (og + 1u == (tg + 1u) * nx) xb_add(&bar[XB_TOPGEN], 1u);
            else XB_SPIN(xb_ld(&bar[XB_TOPGEN]) == tg, bar);
            __builtin_amdgcn_fence(__ATOMIC_ACQUIRE, "agent");
            asm volatile("s_waitcnt vmcnt(0)" ::: "memory");
        } else {
            XB_SPIN(xb_ld(&bar[XB_TOPGEN]) == gen, bar);
            __builtin_amdgcn_fence(__ATOMIC_ACQUIRE, "agent");
            asm volatile("s_waitcnt vmcnt(0)" ::: "memory");
        }
    }
    __syncthreads();
}
struct Frame {
    LAS unsigned char* lds;
    volatile LAS unsigned* MISC;
    gu32* ctl;
    int tid, lane, wave;
    int vcu, G;
};
__device__ __forceinline__ float wave_sum(float v) {
#pragma unroll
    for (int o = 1; o < 64; o <<= 1) v += __shfl_xor(v, o);
    return v;
}
__device__ __forceinline__ int dest_row(int mode, int n0) {
    if (mode == 1) { const int half = n0 / FF, j = n0 % FF; return 256 * (j / 128) + 128 * half + (j % 128); }
    if (mode == 2) { const int s = n0 / 1024, j = n0 % 1024;
        switch (s) { case 0: return NMIXA + j; case 1: return NMIXA + 1024 + j; case 2: return j; case 3: return 1024 + 256 * (j / 128) + (j % 128);
                     case 4: return 1024 + 256 * (j / 128) + 128 + (j % 128); case 5: return 3072 + j; default: return 4096 + j; } }
    return n0;
}
struct TrItem { const float* W; bf16* WT; int K, N, mode, item; };
__device__ __forceinline__ void tr_load(const TrItem& t, int tid, f32x4 (&v)[4]) {
    const int nblk = t.N / 128, kb = t.item / nblk, nb = t.item % nblk, k0 = 64 * kb, n0 = 128 * nb, lane = tid & 63, wv = tid >> 6;
#pragma unroll
    for (int i = 0; i < 4; ++i) { const int kk = 8 * wv + 2 * i + (lane >> 5); v[i] = __builtin_nontemporal_load((const GAS f32x4*)(t.W + (size_t)(k0 + kk) * t.N + n0 + 4 * (lane & 31))); }
}
__device__ __forceinline__ void tr_to_lds(LAS float* tile, int tid, const f32x4 (&v)[4]) {
    const int lane = tid & 63, wv = tid >> 6;
#pragma unroll
    for (int i = 0; i < 4; ++i) { const int kk = 8 * wv + 2 * i + (lane >> 5); LAS float* t = tile + kk * 129 + 4 * (lane & 31); t[0] = v[i].x; t[1] = v[i].y; t[2] = v[i].z; t[3] = v[i].w; }
}
__device__ __forceinline__ void tr_store(const TrItem& t, const LAS float* tile, int tid) {
    const int nblk = t.N / 128, kb = t.item / nblk, nb = t.item % nblk, k0 = 64 * kb, n0 = 128 * nb, r0 = dest_row(t.mode, n0);
#pragma unroll
    for (int j = 0; j < 2; ++j) { const int q = tid + 512 * j, n = q >> 3, c = q & 7; const LAS float* s = tile + (8 * c) * 129 + n;
        v4u o; o.x = pk2(s[0 * 129], s[1 * 129]); o.y = pk2(s[2 * 129], s[3 * 129]); o.z = pk2(s[4 * 129], s[5 * 129]); o.w = pk2(s[6 * 129], s[7 * 129]);
        *(GAS v4u*)(t.WT + (size_t)(r0 + n) * t.K + k0 + 8 * c) = o; }
}
struct Args { const float* in[N_IN]; float* out; unsigned char* ws; int ph_lo, ph_hi, li, pad; };

__device__ __forceinline__ void p0_prologue(Frame& F, const Args& A) {
    const int gw = F.vcu * NWAVES + F.wave, NGW = F.G * NWAVES;
    unsigned char* ws = A.ws;
    {
        constexpr int I_ADA = (NADA / 256) * 32;
        for (int r = gw; r < I_ADA; r += NGW) {
            const int nb = r / 32, kc = r % 32, n = 256 * nb + 4 * F.lane;
            const float s0v = pg8::fsilu(A.in[I_C][32 * kc + (F.lane & 31)]), s1v = pg8::fsilu(A.in[I_C][D + 32 * kc + (F.lane & 31)]);
            const float* wp = A.in[I_WADA] + (size_t)(32 * kc) * NADA + n; f32x4 a0 = {0.f, 0.f, 0.f, 0.f}, a1 = {0.f, 0.f, 0.f, 0.f};
#pragma unroll 16
            for (int kk = 0; kk < 32; ++kk) { const f32x4 w = __builtin_nontemporal_load((const GAS f32x4*)(wp + (size_t)kk * NADA)); a0 += w * __shfl(s0v, kk); a1 += w * __shfl(s1v, kk); }
            float* ap = (float*)(ws + WS_ADAP); *(f32x4*)(ap + (size_t)(kc * 2 + 0) * NADA + n) = a0; *(f32x4*)(ap + (size_t)(kc * 2 + 1) * NADA + n) = a1; }
        constexpr int I_SP = NH * CH;
        for (int r = gw; r < I_SP; r += NGW) { const int t = r % CH; const float* wp = A.in[I_WSP] + (size_t)r * CH + 2 * F.lane; const float w0 = wp[0], w1 = wp[1];
            ((unsigned*)(ws + WS_WSP))[(size_t)r * (CH / 2) + F.lane] = pk2(2 * F.lane <= t ? w0 : 0.f, 2 * F.lane + 1 <= t ? w1 : 0.f); }
    }
    LAS float* tile = (LAS float*)(F.lds + RING_OFF);
    constexpr int I_IN = (D / 64) * (2 * FF / 128), I_OUT = (FF / 64) * (D / 128), I_MIX = (D / 64) * (NMIX / 128), I_SQ = (D / 64) * (D / 128);
    constexpr int NITEMS = I_IN + I_OUT + I_MIX + 3 * I_SQ;
    auto decode = [&](int it) { TrItem t; int r = it;
        if (r < I_IN) { t = TrItem{A.in[I_W1IN], (bf16*)(ws + WS_W1IN), D, 2 * FF, 1, r}; return t; } r -= I_IN;
        if (r < I_OUT) { t = TrItem{A.in[I_W1OUT], (bf16*)(ws + WS_W1OUT), FF, D, 0, r}; return t; } r -= I_OUT;
        if (r < I_MIX) { t = TrItem{A.in[I_WMIXIN], (bf16*)(ws + WS_WMIX), D, NMIX, 2, r}; return t; } r -= I_MIX;
        if (r < I_SQ) { t = TrItem{A.in[I_WAOUT], (bf16*)(ws + WS_WA), D, D, 0, r}; return t; } r -= I_SQ;
        if (r < I_SQ) { t = TrItem{A.in[I_WBOUT], (bf16*)(ws + WS_WB), D, D, 0, r}; return t; } r -= I_SQ;
        t = TrItem{A.in[I_WMIXOUT], (bf16*)(ws + WS_WO), D, D, 0, r}; return t; };
    int it = F.vcu;
    if (it < NITEMS) { TrItem cur = decode(it); f32x4 v[4]; tr_load(cur, F.tid, v);
        for (;;) { tr_to_lds(tile, F.tid, v); __syncthreads();
            const int nit = it + F.G; TrItem nx = cur; const bool more = nit < NITEMS; if (more) { nx = decode(nit); tr_load(nx, F.tid, v); }
            tr_store(cur, tile, F.tid); __syncthreads();
            if (!more) break; cur = nx; it = nit; } }
}
__device__ __forceinline__ void p0_deferred(Frame& F, const Args& A, int idx, int nwg) {
    LAS float* tile = (LAS float*)(F.lds + RING_OFF);
    constexpr int I_IN = (D / 64) * (2 * FF / 128), I_OUT = (FF / 64) * (D / 128);
    auto decode = [&](int it) { TrItem t; if (it < I_IN) t = TrItem{A.in[I_W2IN], (bf16*)(A.ws + WS_W2IN), D, 2 * FF, 1, it}; else t = TrItem{A.in[I_W2OUT], (bf16*)(A.ws + WS_W2OUT), FF, D, 0, it - I_IN}; return t; };
    int it = idx;
    if (it < I_IN + I_OUT) { TrItem cur = decode(it); f32x4 v[4]; tr_load(cur, F.tid, v);
        for (;;) { tr_to_lds(tile, F.tid, v); __syncthreads();
            const int nit = it + nwg; TrItem nx = cur; const bool more = nit < I_IN + I_OUT; if (more) { nx = decode(nit); tr_load(nx, F.tid, v); }
            tr_store(cur, tile, F.tid); __syncthreads();
            if (!more) break; cur = nx; it = nit; } }
}
__device__ __forceinline__ void p1_phase(Frame& F, const Args& A) {
    LAS float* L = (LAS float*)(F.lds + RING_OFF);
    const float* ap = (const float*)(A.ws + WS_ADAP);
#pragma unroll 4
    for (int idx = F.tid; idx < 4096; idx += NWAVES * 64) { const int which = idx >> 11, b = (idx >> 10) & 1, c = idx & 1023;
        const int off = (which == 0 ? 0 : D) + c; float s = A.in[I_BADA][off];
#pragma unroll
        for (int kc = 0; kc < 32; ++kc) s += ap[(size_t)(kc * 2 + b) * NADA + off];
        L[idx] = s; }
    __syncthreads();
    const int gw = F.vcu * NWAVES + F.wave, NGW = F.G * NWAVES;
    {   const float* x = A.in[I_X]; bf16* xb = (bf16*)(A.ws + WS_H);
        for (int b = 0; b < BATCH; ++b) {
            f32x4 gm[4], sh[4];
#pragma unroll
            for (int j = 0; j < 4; ++j) { const int c = 4 * F.lane + 256 * j; const f32x4 gg = *(const f32x4*)(A.in[I_GFFN1] + c); const f32x4 sc = *(const LAS f32x4*)(L + 2048 + b * 1024 + c); gm[j] = gg * (sc + 1.0f); sh[j] = *(const LAS f32x4*)(L + b * 1024 + c); }
            for (int r0 = gw; r0 < T; r0 += 4 * NGW) {
                f32x4 v[4][4];
#pragma unroll
                for (int q = 0; q < 4; ++q) { const int r = r0 + q * NGW; const GAS f32x4* xr = (const GAS f32x4*)(x + ((size_t)b * T + (r < T ? r : r0)) * D) + F.lane;
#pragma unroll
                    for (int j = 0; j < 4; ++j) v[q][j] = xr[64 * j]; }
#pragma unroll
                for (int q = 0; q < 4; ++q) { const int r = r0 + q * NGW; if (r >= T) break; const size_t m = (size_t)b * T + r; float s = 0.f;
#pragma unroll
                    for (int j = 0; j < 4; ++j) s += (v[q][j].x * v[q][j].x + v[q][j].y * v[q][j].y) + (v[q][j].z * v[q][j].z + v[q][j].w * v[q][j].w);
                    const float rstd = 1.f / sqrtf(wave_sum(s) * (1.f / D) + EPS);
                    GAS unsigned long long* o8 = (GAS unsigned long long*)(xb + m * D) + F.lane;
#pragma unroll
                    for (int j = 0; j < 4; ++j) { const f32x4 o = v[q][j] * rstd * gm[j] + sh[j]; o8[64 * j] = (unsigned long long)pk2(o.x, o.y) | ((unsigned long long)pk2(o.z, o.w) << 32); } }
            }
        }
    }
    {
        const int gt = F.vcu * NWAVES * 64 + F.tid;
        if (gt < 2 * NADA) { const int b = gt / NADA, n = gt % NADA; float s = A.in[I_BADA][n];
#pragma unroll
            for (int kc = 0; kc < 32; ++kc) s += ap[(size_t)(kc * 2 + b) * NADA + n];
            ((float*)(A.ws + WS_ADA))[gt] = s; }
    }
    __syncthreads();
}
__device__ __forceinline__ void final_norm_phase(Frame& F, const float* src, const float* g, float* dst) {
    const int gw = F.vcu * NWAVES + F.wave, NGW = F.G * NWAVES;
    f32x4 gg[4];
#pragma unroll
    for (int j = 0; j < 4; ++j) gg[j] = *(const f32x4*)(g + 4 * F.lane + 256 * j);
    for (int m = gw; m < M; m += NGW) {
        const GAS f32x4* xr = (const GAS f32x4*)(src + (size_t)m * D) + F.lane; f32x4 v[4]; float s = 0.f;
#pragma unroll
        for (int j = 0; j < 4; ++j) { v[j] = xr[64 * j]; s += (v[j].x * v[j].x + v[j].y * v[j].y) + (v[j].z * v[j].z + v[j].w * v[j].w); }
        const float rstd = 1.f / sqrtf(wave_sum(s) * (1.f / D) + EPS);
        GAS f32x4* o = (GAS f32x4*)(dst + (size_t)m * D) + F.lane;
#pragma unroll
        for (int j = 0; j < 4; ++j) o[64 * j] = v[j] * rstd * gg[j];
    }
}
__device__ __forceinline__ void mix_phase(Frame& F, const Args& A, bf16* dummy = nullptr) {
    constexpr int LTS = 136;
    LAS bf16* LT = (LAS bf16*)(F.lds + RING_OFF);
    LAS float* ST = (LAS float*)(F.lds + RING_OFF + 36864);
    bf16* BA = (bf16*)(A.ws + WS_ACT); bf16* Z = BA + (size_t)M * D; bf16* U = Z + (size_t)M * D; bf16* GV = U + (size_t)M * D;
    bf16* BAo = dummy ? dummy : BA; bf16* Uo = dummy ? dummy : U;
    const float* vst = (const float*)(A.ws + WS_VST); const bf16* wsp = (const bf16*)(A.ws + WS_WSP);
    const int cg = F.tid & 15, tr = F.tid >> 4, fr = F.lane & 15, fq = F.lane >> 4, w = F.wave;
    for (int un = blockIdx.x; un < BATCH * (T / CH) * NH; un += F.G) {
        const int h = un % NH, n = (un / NH) % (T / CH), b = un / (NH * (T / CH));
        const size_t R0 = (size_t)b * T + (size_t)n * CH; const int C0 = h * CH;
        if (F.tid < CH) { const float* p = vst + (R0 + F.tid) * 32; float s = 0.f, q = 0.f;
#pragma unroll
            for (int i = 0; i < 16; ++i) { s += p[2 * i]; q += p[2 * i + 1]; }
            const float mean = s * (1.f / D), var = q * (1.f / D) - mean * mean; ST[2 * F.tid] = mean; ST[2 * F.tid + 1] = 1.f / sqrtf(var + EPS); }
        __syncthreads();
        {
            float lg[8], lb[8];
#pragma unroll
            for (int e = 0; e < 8; ++e) { lg[e] = A.in[I_LNG][C0 + cg * 8 + e]; lb[e] = A.in[I_LNB][C0 + cg * 8 + e]; }
            LAS unsigned* LT32 = (LAS unsigned*)LT;
#pragma unroll
            for (int ip = 0; ip < 2; ++ip) { const int s = 4 * tr + 2 * ip;
                f32x4 a0, a1, b0, b1; pg8::load8(GV + (R0 + s) * D + C0 + cg * 8, a0, a1); pg8::load8(GV + (R0 + s + 1) * D + C0 + cg * 8, b0, b1);
                const float ma = ST[2 * s], ra = ST[2 * s + 1], mb = ST[2 * s + 2], rb = ST[2 * s + 3];
                const int sw = (((s >> 3) ^ cg) << 3) + (s & 7);
#pragma unroll
                for (int e = 0; e < 4; ++e) {
                    LT32[((cg * 8 + e) * LTS + sw) >> 1] = pk2((a0[e] - ma) * ra * lg[e] + lb[e], (b0[e] - mb) * rb * lg[e] + lb[e]);
                    LT32[((cg * 8 + 4 + e) * LTS + sw) >> 1] = pk2((a1[e] - ma) * ra * lg[4 + e] + lb[4 + e], (b1[e] - mb) * rb * lg[4 + e] + lb[4 + e]); } }
        }
        __syncthreads();
        {
            f32x4 acc[8];
#pragma unroll
            for (int cb = 0; cb < 8; ++cb) acc[cb] = (f32x4){0.f, 0.f, 0.f, 0.f};
            const bf16* wrow = wsp + ((size_t)h * CH + 16 * w + fr) * CH + 8 * fq;
            const int nk = (16 * w + 15) / 32 + 1;
            for (int kk = 0; kk < nk; ++kk) { const bf16x8 y = *(const bf16x8*)(wrow + 32 * kk);
#pragma unroll
                for (int cb = 0; cb < 8; ++cb) { const bf16x8 x = *(const LAS bf16x8*)(LT + (16 * cb + fr) * LTS + (((4 * kk + fq) ^ (2 * cb + (fr >> 3))) << 3)); acc[cb] = __builtin_amdgcn_mfma_f32_16x16x32_bf16(x, y, acc[cb], 0, 0, 0); } }
            const int t = 16 * w + fr; const float bias = A.in[I_BSP][h * CH + t]; const bool odd = fq & 1; const int c16 = odd ? 16 + 4 * (fq - 1) : 4 * fq;
            const bf16* up = U + (R0 + t) * D + C0 + c16; bf16* uo = Uo + (R0 + t) * D + C0 + c16;
            v4u uwv[4];
#pragma unroll
            for (int j = 0; j < 4; ++j) uwv[j] = *(const v4u*)(up + 32 * j);
#pragma unroll
            for (int j = 0; j < 4; ++j) { const v4u wv = uwv[j];
                const unsigned rx = (unsigned)__shfl_xor((int)(odd ? wv.x : wv.z), 16), ry = (unsigned)__shfl_xor((int)(odd ? wv.y : wv.w), 16);
                const unsigned ax = odd ? rx : wv.x, ay = odd ? ry : wv.y, bx = odd ? wv.z : rx, by = odd ? wv.w : ry;
                const f32x4 sa = acc[2 * j] + bias, sb = acc[2 * j + 1] + bias;
                const unsigned ra0 = pk2(__uint_as_float(ax << 16) * sa[0], __uint_as_float(ax & 0xffff0000u) * sa[1]), ra1 = pk2(__uint_as_float(ay << 16) * sa[2], __uint_as_float(ay & 0xffff0000u) * sa[3]);
                const unsigned rb0 = pk2(__uint_as_float(bx << 16) * sb[0], __uint_as_float(bx & 0xffff0000u) * sb[1]), rb1 = pk2(__uint_as_float(by << 16) * sb[2], __uint_as_float(by & 0xffff0000u) * sb[3]);
                const unsigned qx = (unsigned)__shfl_xor((int)(odd ? ra0 : rb0), 16), qy = (unsigned)__shfl_xor((int)(odd ? ra1 : rb1), 16);
                v4u o; if (odd) { o.x = qx; o.y = qy; o.z = rb0; o.w = rb1; } else { o.x = ra0; o.y = ra1; o.z = qx; o.w = qy; }
                *(v4u*)(uo + 32 * j) = o; }
        }
        {
            float w0[8], w1[8], w2[8];
#pragma unroll
            for (int e = 0; e < 8; ++e) { w0[e] = A.in[I_CONVW][C0 + cg * 8 + e]; w1[e] = A.in[I_CONVW][D + C0 + cg * 8 + e]; w2[e] = A.in[I_CONVW][2 * D + C0 + cg * 8 + e]; }
            const int t0 = 4 * tr; const size_t cofs = (size_t)C0 + cg * 8;
            v4u zr[6], br[4]; const bool head = (n == 0 && t0 == 0);
#pragma unroll
            for (int i = 0; i < 6; ++i) { const size_t row = (head && i < 2) ? R0 : R0 + t0 + i - 2; zr[i] = *(const v4u*)(Z + row * D + cofs); }
#pragma unroll
            for (int i = 0; i < 4; ++i) br[i] = *(const v4u*)(BA + (R0 + t0 + i) * D + cofs);
            f32x4 za[2], zb[2];
            pg8::unpack8(zr[0], za[0], za[1]); pg8::unpack8(zr[1], zb[0], zb[1]);
            if (head) { za[0] = za[1] = zb[0] = zb[1] = (f32x4){0.f, 0.f, 0.f, 0.f}; }
#pragma unroll
            for (int i = 0; i < 4; ++i) { f32x4 zc[2], ba[2]; pg8::unpack8(zr[2 + i], zc[0], zc[1]); pg8::unpack8(br[i], ba[0], ba[1]);
                f32x4 o[2];
#pragma unroll
                for (int hh = 0; hh < 2; ++hh)
#pragma unroll
                    for (int e = 0; e < 4; ++e) o[hh][e] = ba[hh][e] * (w0[4 * hh + e] * za[hh][e] + w1[4 * hh + e] * zb[hh][e] + w2[4 * hh + e] * zc[hh][e]);
                pg8::store8(BAo + (R0 + t0 + i) * D + cofs, o[0], o[1]);
                za[0] = zb[0]; za[1] = zb[1]; zb[0] = zc[0]; zb[1] = zc[1]; }
        }
        __syncthreads();
    }
}


#ifndef NAIVE_MIX
#define NAIVE_MIX 0
#endif
__device__ __forceinline__ void mix_phase_naive(Frame& F, const Args& A) {
    LAS float* ST = (LAS float*)(F.lds + RING_OFF);
    bf16* BA = (bf16*)(A.ws + WS_ACT); bf16* Z = BA + (size_t)M * D; bf16* U = Z + (size_t)M * D; bf16* GV = U + (size_t)M * D;
    auto ld = [](const bf16* p) { return __uint_as_float((unsigned)(*p) << 16); };
    for (int un = blockIdx.x; un < BATCH * (T / CH) * NH; un += F.G) {
        const int h = un % NH, n = (un / NH) % (T / CH), b = un / (NH * (T / CH));
        const size_t R0 = (size_t)b * T + (size_t)n * CH; const int C0 = h * CH;
        if (F.tid < CH) { float s = 0.f, q = 0.f; for (int c = 0; c < D; ++c) { const float v = ld(GV + (R0 + F.tid) * D + c); s += v; q += v * v; }
            const float mean = s / D, var = q / D - mean * mean; ST[2 * F.tid] = mean; ST[2 * F.tid + 1] = 1.f / sqrtf(var + EPS); }
        __syncthreads();
        for (int e = F.tid; e < CH * CH; e += NWAVES * 64) { const int t = e / CH, c = e % CH;
            float sv = A.in[I_BSP][h * CH + t];
            for (int s = 0; s <= t; ++s) sv += A.in[I_WSP][((size_t)h * CH + t) * CH + s] * ((ld(GV + (R0 + s) * D + C0 + c) - ST[2 * s]) * ST[2 * s + 1] * A.in[I_LNG][C0 + c] + A.in[I_LNB][C0 + c]);
            const float u = ld(U + (R0 + t) * D + C0 + c);
            float cv = 0.f;
            for (int k = 0; k < 3; ++k) { const int tt = n * CH + t - 2 + k; if (tt >= 0) cv += A.in[I_CONVW][k * D + C0 + c] * ld(Z + ((size_t)b * T + tt) * D + C0 + c); }
            const float ba = ld(BA + (R0 + t) * D + C0 + c);
            U[(R0 + t) * D + C0 + c] = (bf16)f2bf(u * sv); BA[(R0 + t) * D + C0 + c] = (bf16)f2bf(ba * cv); }
        __syncthreads();
    }
}

typedef pg8::EpiResidNorm<0, false, true> EpiRN_a; typedef pg8::EpiResidNorm<0, true, true> EpiRN_b; typedef pg8::EpiResidNorm<1, true, false> EpiRN_c;
__global__ void __launch_bounds__(NWAVES * 64, 2) fwd_kernel(Args args) {
    extern __shared__ __attribute__((aligned(16))) unsigned char lds[];
    Frame F;
    F.lds = (LAS unsigned char*)lds;
    F.MISC = (volatile LAS unsigned*)(F.lds + MISC_OFF);
    F.tid = threadIdx.x; F.lane = F.tid & 63; F.wave = __builtin_amdgcn_readfirstlane(F.tid >> 6);
    F.G = gridDim.x; { const int bx = blockIdx.x; F.vcu = (F.G % 8 == 0) ? (bx % 8) * (F.G / 8) + bx / 8 : bx; }
    unsigned char* ws = args.ws;
    F.ctl = (gu32*)(ws + WS_CTL);
    for (int u = F.tid; u < (LDS_BYTES - LDSCTL_OFF) / 4; u += NWAVES * 64) ((LAS unsigned*)(F.lds + LDSCTL_OFF))[u] = 0u;
    __syncthreads();
    XcdBarrier bar; bar.bar = (unsigned*)(F.ctl + CW_BAR); bar.x = 0; bar.st = nullptr;
    if (!MK_PER_PHASE) bar = xcd_barrier_post((unsigned*)(F.ctl + CW_BAR), F.MISC + 8);
    const int lo = args.ph_lo, hi = args.ph_hi;
#define IN(k) (lo <= (k) && (k) < hi)
#define SEAM(k) do { if (IN(k) && IN((k) + 1)) xcd_barrier(bar); } while (0)
    bf16* H = (bf16*)(ws + WS_H); bf16* HID = (bf16*)(ws + WS_ACT);
    bf16* BA = (bf16*)(ws + WS_ACT); bf16* Zb = BA + (size_t)M * D; bf16* Ub = Zb + (size_t)M * D; bf16* GVb = Ub + (size_t)M * D;
    const float* ada = (const float*)(ws + WS_ADA);
    float* xs = args.out;
#ifndef NAIVE_MASK
#define NAIVE_MASK 0
#endif
#define RUN_GEMM(ph, EPI, g, S, E) do { if ((NAIVE_MASK >> (ph)) & 1) pg8::gemm_phase_naive<EPI, pg8::StaticOrder>(g, S, E); else pg8::gemm_phase<EPI, pg8::StaticOrder, true, true>(F.lds + RING_OFF, g, S, E); } while (0)
    float* ss = (float*)(ws + WS_SS); unsigned* cnt = (unsigned*)(ws + WS_CTL) + CW_CNT;
    bf16* X1B = (bf16*)args.out;
    bf16* X2B = H;
    bf16* XB2 = GVb;
    if (IN(0)) { p0_prologue(F, args); } SEAM(0);
    if (IN(1)) { p1_phase(F, args); } SEAM(1);
    if (IN(2)) { pg8::Gemm g{H, (const bf16*)(ws + WS_W1IN), M, 2 * FF, D}; pg8::StaticOrder S; S.init(M, 2 * FF, F.G, (int)blockIdx.x);
        pg8::EpiSwiglu E{HID, FF}; RUN_GEMM(2, pg8::EpiSwiglu, g, S, E);
        { const int nfull = (M / 256) * (2 * FF / 256) % F.G;
          if (nfull > 0 && (int)blockIdx.x >= nfull) p0_deferred(F, args, (int)blockIdx.x - nfull, F.G - nfull);
          else if (nfull == 0) p0_deferred(F, args, (int)blockIdx.x, F.G); } } SEAM(2);
    if (IN(3)) { pg8::Gemm g{HID, (const bf16*)(ws + WS_W1OUT), M, D, FF}; pg8::StaticOrder S; S.init(M, D, F.G, (int)blockIdx.x);
        EpiRN_a E{args.in[I_X], X1B, ada, 2 * D, 0.5f, args.in[I_GMIX], 3 * D, 4 * D, H, ss, cnt}; RUN_GEMM(3, EpiRN_a, g, S, E); } SEAM(3);
    if (IN(4)) { pg8::Gemm g{H, (const bf16*)(ws + WS_WMIX), M, NMIXA, D}; pg8::StaticOrder S; S.init(M, NMIXA, F.G, (int)blockIdx.x);
        pg8::EpiMixA E{BA, Zb, Ub, GVb, (float*)(ws + WS_VST)}; RUN_GEMM(4, pg8::EpiMixA, g, S, E); } SEAM(4);
    if (IN(5)) {
#if NAIVE_MIX
        mix_phase_naive(F, args);
#else
        mix_phase(F, args);
#endif
    } SEAM(5);
#ifdef PROBE_BAR10
    for (int i = 0; i < 10; ++i) xcd_barrier(bar);
#endif
    if (IN(6)) { pg8::Gemm g{H, (const bf16*)(ws + WS_WMIX) + (size_t)NMIXA * D, M, NMIXB, D}; pg8::StaticOrder S; S.init(M, NMIXB, F.G, (int)blockIdx.x);
        pg8::EpiGates E{Zb, GVb}; RUN_GEMM(6, pg8::EpiGates, g, S, E); }
    if (IN(6) && IN(7) && F.G != 256) xcd_barrier(bar);
    if (IN(7)) { pg8::Gemm g{BA, (const bf16*)(ws + WS_WA), M, D, D, Ub, (const bf16*)(ws + WS_WB)}; pg8::DualOrder S; S.base.init(M, D, F.G, (int)blockIdx.x);
        pg8::EpiDualGate E{Zb, GVb, (bf16*)(ws + WS_G)};
        if ((NAIVE_MASK >> 7) & 1) pg8::gemm_phase_naive<pg8::EpiDualGate, pg8::DualOrder>(g, S, E); else pg8::gemm_phase<pg8::EpiDualGate, pg8::DualOrder, true, true>(F.lds + RING_OFF, g, S, E); } SEAM(7);
    if (IN(8)) { pg8::Gemm g{(const bf16*)(ws + WS_G), (const bf16*)(ws + WS_WO), M, D, D}; pg8::StaticOrder S; S.init(M, D, F.G, (int)blockIdx.x);
        EpiRN_b E{X1B, X2B, ada, 5 * D, 1.0f, args.in[I_GFFN2], 6 * D, 7 * D, XB2, ss + M, cnt + 4096}; RUN_GEMM(8, EpiRN_b, g, S, E); } SEAM(8);
    if (IN(9)) { pg8::Gemm g{XB2, (const bf16*)(ws + WS_W2IN), M, 2 * FF, D}; pg8::StaticOrder S; S.init(M, 2 * FF, F.G, (int)blockIdx.x);
        pg8::EpiSwiglu E{HID, FF}; RUN_GEMM(9, pg8::EpiSwiglu, g, S, E); } SEAM(9);
    if (IN(10)) { pg8::Gemm g{HID, (const bf16*)(ws + WS_W2OUT), M, D, FF}; pg8::StaticOrder S; S.init(M, D, F.G, (int)blockIdx.x);
        EpiRN_c E{X2B, xs, ada, 8 * D, 0.5f, args.in[I_GFINAL], 0, 0, nullptr, ss + 2 * M, cnt + 8192}; RUN_GEMM(10, EpiRN_c, g, S, E); }
#undef IN
#undef SEAM
}

extern "C" void kernel_launch(void* const* d_in, const int* in_sizes, int n_in, void* d_out, int out_size, void* d_ws, size_t ws_size, hipStream_t stream) {
    static int grid = 0;
    if (grid == 0) {
        if (n_in != N_IN || in_sizes[0] != M * D || out_size != M * D || ws_size < WS_END) { fprintf(stderr, "kernel_launch: unexpected shapes (n_in %d, in0 %d, out %d, ws %zu)\n", n_in, n_in > 0 ? in_sizes[0] : -1, out_size, ws_size); grid = -1; return; }
        int dev = 0, cus = 0, per_cu = 0;
        if (hipGetDevice(&dev) != hipSuccess || hipDeviceGetAttribute(&cus, hipDeviceAttributeMultiprocessorCount, dev) != hipSuccess) { grid = -1; return; }
        if (hipFuncSetAttribute((const void*)fwd_kernel, hipFuncAttributeMaxDynamicSharedMemorySize, LDS_BYTES) != hipSuccess) { fprintf(stderr, "kernel_launch: hipFuncSetAttribute failed\n"); grid = -1; return; }
        if (hipOccupancyMaxActiveBlocksPerMultiprocessor(&per_cu, (const void*)fwd_kernel, NWAVES * 64, LDS_BYTES) != hipSuccess || per_cu < 1) { fprintf(stderr, "kernel_launch: occupancy query reports %d workgroups per CU\n", per_cu); per_cu = 1; }
        (void)hipGetLastError();
        grid = cus;
    }
    if (grid < 0) return;
    (void)hipMemsetAsync((char*)d_ws + WS_CTL, 0, CTL_ZERO_BYTES, stream);
    Args a{};
    for (int i = 0; i < N_IN; ++i) a.in[i] = (const float*)d_in[i];
    a.out = (float*)d_out; a.ws = (unsigned char*)d_ws;
#if MK_PER_PHASE
    for (int p = 0; p < N_PHASES; ++p) { a.ph_lo = p; a.ph_hi = p + 1; a.li = p; hipLaunchKernelGGL(fwd_kernel, dim3(grid), dim3(NWAVES * 64), LDS_BYTES, stream, a); }
#else
    a.ph_lo = 0; a.ph_hi = N_PHASES; a.li = 0;
    hipLaunchKernelGGL(fwd_kernel, dim3(grid), dim3(NWAVES * 64), LDS_BYTES, stream, a);
#ifdef PROBE_NREP
    for (int rep = 1; rep < PROBE_NREP; ++rep) { (void)hipMemsetAsync((char*)d_ws + WS_CTL, 0, CTL_ZERO_BYTES, stream); hipLaunchKernelGGL(fwd_kernel, dim3(grid), dim3(NWAVES * 64), LDS_BYTES, stream, a); }
#endif
#endif
}
```

```cpp
#include <hip/hip_runtime.h>
#include <cstdio>
#include <cstdint>
namespace pg8 {
#define PG8_LAS __attribute__((address_space(3)))
typedef unsigned short bf16_t;
typedef short bf16x8 __attribute__((ext_vector_type(8)));
typedef float f32x4 __attribute__((ext_vector_type(4)));
typedef unsigned u32x4 __attribute__((ext_vector_type(4)));
constexpr int BM = 256, BK = 64, HALF = 128, HTB = HALF * BK * 2  , STAGE_BYTES = 8 * HTB, NXCD = 8, WGM = 8;

__host__ __device__ __forceinline__ int lds_byte(int r, int c) { const int st = (r >> 4) * 2 + (c >> 5), rr = r & 15, cc = c & 31, ob = rr * 64 + cc * 2; return st * 1024 + (ob ^ (((ob >> 9) & 1) << 5)); }
__host__ __device__ __forceinline__ void stage_rc(int b, int& R, int& C) { const int st = b / 1024, sb = b % 1024, swz = sb ^ (((sb >> 9) & 1) << 5); R = (st >> 1) * 16 + swz / 64; C = (st & 1) * 32 + (swz % 64) / 2; }
__host__ __device__ __forceinline__ int perm32(int rho) { const int n = rho >> 4, i = rho & 15; return 8 * (i >> 2) + 4 * n + (i & 3); }

struct Unit { int pm, pn, sel; };
struct Gemm { const bf16_t* A; const bf16_t* Bt; int M, N, K; const bf16_t* A2 = nullptr; const bf16_t* Bt2 = nullptr; };

struct StaticOrder {
    int nM, nN, nwg, G, c;
    __host__ __device__ void init(int M, int N, int G_, int c_) { nM = M / BM; nN = N / BM; nwg = nM * nN; G = G_; c = c_; }
    __host__ __device__ bool next(int i, Unit& u) const {
        const long L = (long)i * G + c; if (L >= nwg) return false;
        int wgid = (int)L; { const int q = nwg / NXCD, r = nwg % NXCD, xcd = wgid % NXCD, off = wgid / NXCD; wgid = (xcd < r ? xcd * (q + 1) : r * (q + 1) + (xcd - r) * q) + off; }
        const int nig = WGM * nN, gid = wgid / nig, fm = gid * WGM, gsz = (nM - fm) < WGM ? (nM - fm) : WGM;
        u.pm = fm + ((wgid % nig) % gsz); u.pn = (wgid % nig) / gsz; u.sel = 0; return true;
    }
    __device__ __forceinline__ void a_ready(const Unit&) const {}
    __device__ __forceinline__ void done(const Unit&) const {}
};

struct DualOrder { StaticOrder base;
    __host__ __device__ bool next(int i, Unit& u) const { if (!base.next(i >> 1, u)) return false; u.sel = i & 1; return true; }
    __device__ __forceinline__ void a_ready(const Unit&) const {}
    __device__ __forceinline__ void done(const Unit&) const {}
};
typedef __bf16 bf16x2_hw __attribute__((ext_vector_type(2)));
typedef float f32x2_hw __attribute__((ext_vector_type(2)));
__device__ __forceinline__ unsigned cvt_pk_bf16(float lo, float hi) { const f32x2_hw f = {lo, hi}; return __builtin_bit_cast(unsigned, __builtin_convertvector(f, bf16x2_hw)); }
typedef float f32x2 __attribute__((ext_vector_type(2)));
template <class Epi, class Sched, bool ALIGN_EPI = false, bool SP2 = false>
__device__ __forceinline__ void gemm_phase(PG8_LAS unsigned char* lds, const Gemm g, const Sched S, const Epi E) {
    const int tid = threadIdx.x, wid = __builtin_amdgcn_readfirstlane(tid >> 6), lane = tid & 63, wr = wid >> 2, wc = wid & 3, fr = lane & 15, fq = lane >> 4;
    const int K = g.K, nt = K / BK;
    unsigned voffA[2], voffB[2];
#pragma unroll
    for (int i = 0; i < 2; ++i) { int R, C; stage_rc(tid * 16 + i * 8192, R, C); const int Rb = Epi::PERM ? ((R & ~31) + perm32(R & 31)) : R;
        voffA[i] = (unsigned)(R * K + C) * 2u; voffB[i] = (unsigned)(Rb * K + C) * 2u; }
    const size_t kstep = (size_t)(BK * 2);
    const size_t hstep = (size_t)HALF * K * 2;
    const size_t tstep = 2 * hstep;
    const unsigned ldsw = (unsigned)wid * 1024u;
    const int aoff = lds_byte(wr * 64 + fr, fq * 8), boff = lds_byte(wc * 32 + fr, fq * 8);
#define PG8_SA(b, h) (((b) * 2 + (h)) * HTB)
#define PG8_SB(b, h) ((4 + (b) * 2 + (h)) * HTB)
#define PG8_STAGE(bufoff, gbase, voff) do { _Pragma("unroll") for (int _i = 0; _i < 2; ++_i) \
        __builtin_amdgcn_global_load_lds((const unsigned*)((const char*)(gbase) + (voff)[_i]), (PG8_LAS unsigned*)(lds + (bufoff) + ldsw + _i * 8192), 16, 0, 0); } while (0)
#define PG8_LDA(dst, b, h) do { _Pragma("unroll") for (int m = 0; m < 4; ++m) _Pragma("unroll") for (int k = 0; k < 2; ++k) dst[m][k] = *(const PG8_LAS bf16x8*)(lds + PG8_SA(b, h) + aoff + m * 2048 + k * 1024); } while (0)
#define PG8_LDB(dst, b, h) do { _Pragma("unroll") for (int n = 0; n < 2; ++n) _Pragma("unroll") for (int k = 0; k < 2; ++k) dst[n][k] = *(const PG8_LAS bf16x8*)(lds + PG8_SB(b, h) + boff + n * 2048 + k * 1024); } while (0)
#define PG8_MMA(ai, bj, At, Bt) do { __builtin_amdgcn_s_setprio(1); _Pragma("unroll") for (int m = 0; m < 4; ++m) _Pragma("unroll") for (int n = 0; n < 2; ++n) _Pragma("unroll") for (int k = 0; k < 2; ++k) \
        acc[ai][bj][m][n] = __builtin_amdgcn_mfma_f32_16x16x32_bf16(Bt[n][k], At[m][k], acc[ai][bj][m][n], 0, 0, 0); __builtin_amdgcn_s_setprio(0); } while (0)
#define PG8_WAIT_V(n) asm volatile("s_waitcnt vmcnt(" #n ")" ::: "memory")
#define PG8_WAIT_L(n) asm volatile("s_waitcnt lgkmcnt(" #n ")" ::: "memory")
#define PG8_BAR __builtin_amdgcn_s_barrier()
#define PG8_SCHED __builtin_amdgcn_sched_barrier(0)
    Unit cur, nxt; int ui = 0;
    if (!S.next(0, cur)) return;
    f32x4 acc[2][2][4][2];
#pragma unroll
    for (int a = 0; a < 2; ++a)
#pragma unroll
        for (int b = 0; b < 2; ++b)
#pragma unroll
            for (int m = 0; m < 4; ++m)
#pragma unroll
                for (int n = 0; n < 2; ++n) acc[a][b][m][n] = (f32x4){0.f, 0.f, 0.f, 0.f};
    bf16x8 At[4][2], B0[2][2], B1[2][2];
    const char* cA = (const char*)(Epi::DUAL && cur.sel ? g.A2 : g.A) + (size_t)cur.pm * tstep; const char* cB = (const char*)(Epi::DUAL && cur.sel ? g.Bt2 : g.Bt) + (size_t)cur.pn * tstep;
    S.a_ready(cur);
    if constexpr (SP2) {
        PG8_STAGE(PG8_SB(0, 0), cB, voffB); PG8_STAGE(PG8_SB(0, 1), cB + hstep, voffB); PG8_STAGE(PG8_SA(0, 0), cA, voffA); PG8_STAGE(PG8_SA(0, 1), cA + hstep, voffA);
        if (wr == 1) PG8_BAR;
        PG8_WAIT_V(2); PG8_BAR;
        PG8_STAGE(PG8_SB(1, 0), cB + kstep, voffB); PG8_STAGE(PG8_SA(1, 0), cA + kstep, voffA); PG8_STAGE(PG8_SB(1, 1), cB + hstep + kstep, voffB);
        PG8_WAIT_V(6); PG8_BAR;
    } else {
        PG8_STAGE(PG8_SB(0, 0), cB, voffB); PG8_STAGE(PG8_SA(0, 0), cA, voffA); PG8_STAGE(PG8_SB(0, 1), cB + hstep, voffB); PG8_STAGE(PG8_SA(0, 1), cA + hstep, voffA);
        if (wr == 1) PG8_BAR;
        PG8_WAIT_V(4); PG8_BAR;
        PG8_STAGE(PG8_SB(1, 0), cB + kstep, voffB); PG8_STAGE(PG8_SA(1, 0), cA + kstep, voffA); PG8_STAGE(PG8_SB(1, 1), cB + hstep + kstep, voffB);
        PG8_WAIT_V(6); PG8_BAR;
    }
    for (;;) {
        const bool has_next = S.next(ui + 1, nxt);
        const char* nA = has_next ? (const char*)(Epi::DUAL && nxt.sel ? g.A2 : g.A) + (size_t)nxt.pm * tstep : cA; const char* nB = has_next ? (const char*)(Epi::DUAL && nxt.sel ? g.Bt2 : g.Bt) + (size_t)nxt.pn * tstep : cB;
        for (int t = 0; t < nt; t += 2) {
            const bool last = (t == nt - 2);
            const char* a1 = cA + (size_t)(t + 1) * kstep;
            const char* a2 = last ? nA : cA + (size_t)(t + 2) * kstep; const char* b2 = last ? nB : cB + (size_t)(t + 2) * kstep;
            const char* a3 = a2 + kstep; const char* b3 = b2 + kstep;
            if (last && has_next) S.a_ready(nxt);
            if constexpr (SP2) {
            PG8_LDB(B0, 0, 0); PG8_LDB(B1, 0, 1); PG8_SCHED; PG8_LDA(At, 0, 0); PG8_STAGE(PG8_SA(1, 1), a1 + hstep, voffA);
            PG8_WAIT_V(8); PG8_WAIT_L(0); PG8_BAR; PG8_MMA(0, 0, At, B0); PG8_MMA(0, 1, At, B1); PG8_BAR; PG8_SCHED;
            PG8_LDA(At, 0, 1); PG8_STAGE(PG8_SB(0, 0), b2, voffB); PG8_STAGE(PG8_SB(0, 1), b2 + hstep, voffB); PG8_STAGE(PG8_SA(0, 0), a2, voffA);
            PG8_WAIT_V(8); PG8_WAIT_L(0); PG8_BAR; PG8_MMA(1, 0, At, B0); PG8_MMA(1, 1, At, B1); PG8_BAR; PG8_SCHED;
            PG8_LDB(B0, 1, 0); PG8_LDB(B1, 1, 1); PG8_SCHED; PG8_LDA(At, 1, 0); PG8_STAGE(PG8_SA(0, 1), a2 + hstep, voffA);
            PG8_WAIT_V(8); PG8_WAIT_L(0); PG8_BAR; PG8_MMA(0, 0, At, B0); PG8_MMA(0, 1, At, B1); PG8_BAR; PG8_SCHED;
            PG8_LDA(At, 1, 1); PG8_STAGE(PG8_SB(1, 0), b3, voffB); PG8_STAGE(PG8_SB(1, 1), b3 + hstep, voffB); PG8_STAGE(PG8_SA(1, 0), a3, voffA);
            PG8_WAIT_V(8); PG8_WAIT_L(0); PG8_BAR; PG8_MMA(1, 0, At, B0); PG8_MMA(1, 1, At, B1); PG8_BAR; PG8_SCHED;
            } else {
            PG8_LDB(B0, 0, 0); PG8_SCHED; PG8_LDA(At, 0, 0); PG8_STAGE(PG8_SA(1, 1), a1 + hstep, voffA);
            PG8_WAIT_L(8); PG8_BAR; PG8_WAIT_L(0); PG8_MMA(0, 0, At, B0); PG8_BAR; PG8_SCHED;
            PG8_LDB(B1, 0, 1); PG8_STAGE(PG8_SB(0, 0), b2, voffB);
            PG8_BAR; PG8_WAIT_L(0); PG8_MMA(0, 1, At, B1); PG8_BAR;
            PG8_LDA(At, 0, 1); PG8_STAGE(PG8_SA(0, 0), a2, voffA);
            PG8_BAR; PG8_WAIT_L(0); PG8_MMA(1, 0, At, B0); PG8_BAR; PG8_SCHED;
            PG8_STAGE(PG8_SB(0, 1), b2 + hstep, voffB);
            PG8_WAIT_V(6); PG8_BAR; PG8_MMA(1, 1, At, B1); PG8_BAR;
            PG8_LDB(B0, 1, 0); PG8_SCHED; PG8_LDA(At, 1, 0); PG8_STAGE(PG8_SA(0, 1), a2 + hstep, voffA);
            PG8_WAIT_L(8); PG8_BAR; PG8_WAIT_L(0); PG8_MMA(0, 0, At, B0); PG8_BAR; PG8_SCHED;
            PG8_LDB(B1, 1, 1); PG8_STAGE(PG8_SB(1, 0), b3, voffB);
            PG8_BAR; PG8_WAIT_L(0); PG8_MMA(0, 1, At, B1); PG8_BAR;
            PG8_LDA(At, 1, 1); PG8_STAGE(PG8_SA(1, 0), a3, voffA);
            PG8_BAR; PG8_WAIT_L(0); PG8_MMA(1, 0, At, B0); PG8_BAR; PG8_SCHED;
            PG8_STAGE(PG8_SB(1, 1), b3 + hstep, voffB);
            PG8_WAIT_V(6); PG8_BAR; PG8_MMA(1, 1, At, B1); PG8_BAR;
            }
        }
        if constexpr (ALIGN_EPI) { if (wr == 0) PG8_BAR; }
        if constexpr (!Epi::AFTER_DRAIN) { E(acc, cur, wr, wc, fr, fq); S.done(cur); }
        if (!has_next) break;
        if (!(Epi::DUAL && cur.sel == 0))
#pragma unroll
        for (int a = 0; a < 2; ++a)
#pragma unroll
            for (int b = 0; b < 2; ++b)
#pragma unroll
                for (int m = 0; m < 4; ++m)
#pragma unroll
                    for (int n = 0; n < 2; ++n) acc[a][b][m][n] = (f32x4){0.f, 0.f, 0.f, 0.f};
        cur = nxt; cA = nA; cB = nB; ++ui;
        if constexpr (ALIGN_EPI) { if (wr == 1) PG8_BAR; }
    }
    PG8_WAIT_V(0);
    if constexpr (!ALIGN_EPI) { if (wr == 0) PG8_BAR; }
    PG8_BAR;
    if constexpr (Epi::AFTER_DRAIN) { E.fused(acc, cur, wr, wc, fr, fq, lds, wid, lane); S.done(cur); }
#undef PG8_SA
#undef PG8_SB
#undef PG8_STAGE
#undef PG8_LDA
#undef PG8_LDB
#undef PG8_MMA
#undef PG8_WAIT_V
#undef PG8_WAIT_L
#undef PG8_BAR
#undef PG8_SCHED
}
__device__ __forceinline__ float fsig(float x) { return __builtin_amdgcn_rcpf(1.0f + __builtin_amdgcn_exp2f(-1.44269504089f * x)); }
__device__ __forceinline__ float fsilu(float x) { return x * fsig(x); }
__device__ __forceinline__ float fgelu(float x) { const float u = 1.5957691216057308f * (x + 0.044715f * x * x * x); return x * fsig(u); }
__device__ __forceinline__ f32x4 vsig(const f32x4 x) { const f32x4 t = x * (-1.44269504089f); f32x4 e; e[0] = __builtin_amdgcn_exp2f(t[0]); e[1] = __builtin_amdgcn_exp2f(t[1]); e[2] = __builtin_amdgcn_exp2f(t[2]); e[3] = __builtin_amdgcn_exp2f(t[3]);
    const f32x4 d = e + 1.0f; f32x4 r; r[0] = __builtin_amdgcn_rcpf(d[0]); r[1] = __builtin_amdgcn_rcpf(d[1]); r[2] = __builtin_amdgcn_rcpf(d[2]); r[3] = __builtin_amdgcn_rcpf(d[3]); return r; }
__device__ __forceinline__ f32x4 vsilu(const f32x4 x) { return x * vsig(x); }
__device__ __forceinline__ f32x4 vgelu(const f32x4 x) { const f32x4 u = (x * x * 0.044715f + 1.0f) * x * 1.5957691216057308f; return x * vsig(u); }
__device__ __forceinline__ void store8(bf16_t* p, f32x4 a, f32x4 b) { u32x4 w; w.x = cvt_pk_bf16(a[0], a[1]); w.y = cvt_pk_bf16(a[2], a[3]); w.z = cvt_pk_bf16(b[0], b[1]); w.w = cvt_pk_bf16(b[2], b[3]);
#ifdef NT_STORES
    __builtin_nontemporal_store(w, (u32x4*)p);
#else
    *(u32x4*)p = w;
#endif
}
__device__ __forceinline__ void load8(const bf16_t* p, f32x4& a, f32x4& b) { const u32x4 w = *(const u32x4*)p;
    a[0] = __uint_as_float(w.x << 16); a[1] = __uint_as_float(w.x & 0xffff0000u); a[2] = __uint_as_float(w.y << 16); a[3] = __uint_as_float(w.y & 0xffff0000u);
    b[0] = __uint_as_float(w.z << 16); b[1] = __uint_as_float(w.z & 0xffff0000u); b[2] = __uint_as_float(w.w << 16); b[3] = __uint_as_float(w.w & 0xffff0000u); }
__device__ __forceinline__ void unpack8(const u32x4 w, f32x4& a, f32x4& b) {
    a[0] = __uint_as_float(w.x << 16); a[1] = __uint_as_float(w.x & 0xffff0000u); a[2] = __uint_as_float(w.y << 16); a[3] = __uint_as_float(w.y & 0xffff0000u);
    b[0] = __uint_as_float(w.z << 16); b[1] = __uint_as_float(w.z & 0xffff0000u); b[2] = __uint_as_float(w.w << 16); b[3] = __uint_as_float(w.w & 0xffff0000u); }
#define EPI_FOR_ROWS _Pragma("unroll") for (int ai = 0; ai < 2; ++ai) _Pragma("unroll") for (int m = 0; m < 4; ++m)

struct Affine { const float* ss; const float* bias;
    int ldb;
    __device__ __forceinline__ void apply(f32x4 (&acc)[2][2][4][2], const Unit& u, int wr, int wc, int fr, int fq, int pn_off) const {
        const int row0 = u.pm * BM + wr * 64 + fr; const float* bp = bias + (size_t)(u.pm >> 5) * ldb + (u.pn + pn_off) * BM + wc * 32 + 8 * fq;
        f32x4 bv[2][2];
#pragma unroll
        for (int bj = 0; bj < 2; ++bj)
#pragma unroll
            for (int n = 0; n < 2; ++n) bv[bj][n] = *(const f32x4*)(bp + bj * HALF + 4 * n);
#pragma unroll
        for (int ai = 0; ai < 2; ++ai)
#pragma unroll
            for (int m = 0; m < 4; ++m) { const float rstd = 1.0f / sqrtf(ss[row0 + ai * HALF + m * 16] * (1.0f / 1024.0f) + 1e-6f);
#pragma unroll
                for (int bj = 0; bj < 2; ++bj)
#pragma unroll
                    for (int n = 0; n < 2; ++n) acc[ai][bj][m][n] = acc[ai][bj][m][n] * rstd + bv[bj][n]; }
    }
};
struct EpiSwiglu { static constexpr bool PERM = true, AFTER_DRAIN = false, DUAL = false; bf16_t* O; int ldc;
    __device__ __forceinline__ void operator()(f32x4 (&acc)[2][2][4][2], const Unit& u, int wr, int wc, int fr, int fq) const {
        const int row0 = u.pm * BM + wr * 64 + fr, col0 = u.pn * HALF + wc * 32 + 8 * fq;
        EPI_FOR_ROWS { bf16_t* rowp = O + (size_t)(row0 + ai * HALF + m * 16) * ldc + col0; f32x4 v0, v1;
#pragma unroll
            for (int e = 0; e < 1; ++e) { v0 = vsilu(acc[ai][0][m][0]) * acc[ai][1][m][0]; v1 = vsilu(acc[ai][0][m][1]) * acc[ai][1][m][1]; }
            store8(rowp, v0, v1); }
    }
};
struct EpiMixA { static constexpr bool PERM = true, AFTER_DRAIN = false, DUAL = false; bf16_t *BA, *Z, *U, *GV; float* vst;
    __device__ __forceinline__ void operator()(f32x4 (&acc)[2][2][4][2], const Unit& u, int wr, int wc, int fr, int fq) const {
        const int row0 = u.pm * BM + wr * 64 + fr, pn = u.pn, cw = wc * 32 + 8 * fq;
        if (pn < 4) {
            EPI_FOR_ROWS { bf16_t* rowp = BA + (size_t)(row0 + ai * HALF + m * 16) * 1024 + pn * 256 + cw;
#pragma unroll
                for (int bj = 0; bj < 2; ++bj) store8(rowp + bj * HALF, acc[ai][bj][m][0], acc[ai][bj][m][1]); }
        } else if (pn < 12) {
            EPI_FOR_ROWS { bf16_t* rowp = Z + (size_t)(row0 + ai * HALF + m * 16) * 1024 + (pn - 4) * HALF + cw;
                store8(rowp, acc[ai][0][m][0] * acc[ai][1][m][0], acc[ai][0][m][1] * acc[ai][1][m][1]); }
        } else if (pn < 16) {
            EPI_FOR_ROWS { bf16_t* rowp = U + (size_t)(row0 + ai * HALF + m * 16) * 1024 + (pn - 12) * 256 + cw;
#pragma unroll
                for (int bj = 0; bj < 2; ++bj) { f32x4 v0, v1;
#pragma unroll
                    for (int e = 0; e < 1; ++e) { v0 = vgelu(acc[ai][bj][m][0]); v1 = vgelu(acc[ai][bj][m][1]); }
                    store8(rowp + bj * HALF, v0, v1); } }
        } else {
            EPI_FOR_ROWS { const int row = row0 + ai * HALF + m * 16; bf16_t* rowp = GV + (size_t)row * 1024 + (pn - 16) * 256 + cw; float s = 0.f, q = 0.f;
#pragma unroll
                for (int bj = 0; bj < 2; ++bj) { f32x4 v0, v1;
#pragma unroll
                    for (int e = 0; e < 1; ++e) { v0 = vgelu(acc[ai][bj][m][0]); v1 = vgelu(acc[ai][bj][m][1]); const f32x4 sv = v0 + v1, qv = v0 * v0 + v1 * v1; s += (sv[0] + sv[1]) + (sv[2] + sv[3]); q += (qv[0] + qv[1]) + (qv[2] + qv[3]); }
                    store8(rowp + bj * HALF, v0, v1); }
                s += __shfl_xor(s, 16); s += __shfl_xor(s, 32); q += __shfl_xor(q, 16); q += __shfl_xor(q, 32);
                if (fq == 0) *(f32x2*)(vst + ((size_t)row * 16 + (pn - 16) * 4 + wc) * 2) = (f32x2){s, q}; }
        }
    }
};
struct EpiGates { static constexpr bool PERM = true, AFTER_DRAIN = false, DUAL = false; bf16_t *SGA, *SGB;
    __device__ __forceinline__ void operator()(f32x4 (&acc)[2][2][4][2], const Unit& u, int wr, int wc, int fr, int fq) const {
        const int row0 = u.pm * BM + wr * 64 + fr, pn = u.pn; bf16_t* base = (pn < 4 ? SGA : SGB) + (pn & 3) * 256 + wc * 32 + 8 * fq;
        EPI_FOR_ROWS { bf16_t* rowp = base + (size_t)(row0 + ai * HALF + m * 16) * 1024;
#pragma unroll
            for (int bj = 0; bj < 2; ++bj) { f32x4 v0, v1;
#pragma unroll
                for (int e = 0; e < 1; ++e) { v0 = vsig(acc[ai][bj][m][0]); v1 = vsig(acc[ai][bj][m][1]); }
                store8(rowp + bj * HALF, v0, v1); } }
    }
};
template <bool ADD> struct EpiGateAcc { static constexpr bool PERM = true, AFTER_DRAIN = false, DUAL = false; const bf16_t* gate; bf16_t* O;
    __device__ __forceinline__ void operator()(const f32x4 (&acc)[2][2][4][2], const Unit& u, int wr, int wc, int fr, int fq) const {
        const int row0 = u.pm * BM + wr * 64 + fr, col0 = u.pn * 256 + wc * 32 + 8 * fq;
        EPI_FOR_ROWS { const size_t off = (size_t)(row0 + ai * HALF + m * 16) * 1024 + col0;
#pragma unroll
            for (int bj = 0; bj < 2; ++bj) { f32x4 g0, g1, v0, v1; load8(gate + off + bj * HALF, g0, g1); v0 = g0 * acc[ai][bj][m][0]; v1 = g1 * acc[ai][bj][m][1];
                if (ADD) { f32x4 t0, t1; load8(O + off + bj * HALF, t0, t1); v0 += t0; v1 += t1; }
                store8(O + off + bj * HALF, v0, v1); }
            asm volatile("" ::: "memory"); }
    }
};
struct EpiDualGate { static constexpr bool PERM = true, AFTER_DRAIN = false, DUAL = true; const bf16_t *sga, *sgb; bf16_t* O;
    __device__ __forceinline__ void operator()(f32x4 (&acc)[2][2][4][2], const Unit& u, int wr, int wc, int fr, int fq) const {
        const int row0 = u.pm * BM + wr * 64 + fr, col0 = u.pn * 256 + wc * 32 + 8 * fq;
        if (u.sel == 0) {
            EPI_FOR_ROWS { const size_t off = (size_t)(row0 + ai * HALF + m * 16) * 1024 + col0;
#pragma unroll
                for (int bj = 0; bj < 2; ++bj) { f32x4 a0, a1, b0, b1; load8(sga + off + bj * HALF, a0, a1); load8(sgb + off + bj * HALF, b0, b1);
#pragma unroll
                    for (int e = 0; e < 4; ++e) { acc[ai][bj][m][0][e] *= a0[e] * __builtin_amdgcn_rcpf(fmaxf(b0[e], 1e-30f)); acc[ai][bj][m][1][e] *= a1[e] * __builtin_amdgcn_rcpf(fmaxf(b1[e], 1e-30f)); } }
                asm volatile("" ::: "memory"); }
        } else {
            EPI_FOR_ROWS { const size_t off = (size_t)(row0 + ai * HALF + m * 16) * 1024 + col0;
#pragma unroll
                for (int bj = 0; bj < 2; ++bj) { f32x4 b0, b1, v0, v1; load8(sgb + off + bj * HALF, b0, b1);
#pragma unroll
                    for (int e = 0; e < 4; ++e) { v0[e] = acc[ai][bj][m][0][e] * fmaxf(b0[e], 1e-30f); v1[e] = acc[ai][bj][m][1][e] * fmaxf(b1[e], 1e-30f); }
                    store8(O + off + bj * HALF, v0, v1); }
                asm volatile("" ::: "memory"); }
        }
    }
};
template <int MODE, bool BASE16, bool OUT16> struct EpiResidNorm { static constexpr bool PERM = false, AFTER_DRAIN = true, DUAL = false;
    __device__ __forceinline__ static f32x4 ld4bf(const bf16_t* p) { const f32x2 w = __builtin_nontemporal_load((const f32x2*)p);     const unsigned lo = __float_as_uint(w.x), hi = __float_as_uint(w.y);
        return (f32x4){__uint_as_float(lo << 16), __uint_as_float(lo & 0xffff0000u), __uint_as_float(hi << 16), __uint_as_float(hi & 0xffff0000u)}; }
    __device__ __forceinline__ static void st8pair(bf16_t* rowp_n0, const f32x4 h0, const f32x4 h1, int fq) {
        const unsigned a0 = cvt_pk_bf16(h0[0], h0[1]), a1 = cvt_pk_bf16(h0[2], h0[3]), b0 = cvt_pk_bf16(h1[0], h1[1]), b1 = cvt_pk_bf16(h1[2], h1[3]); const bool odd = fq & 1;
        const unsigned rx = (unsigned)__shfl_xor((int)(odd ? a0 : b0), 16), ry = (unsigned)__shfl_xor((int)(odd ? a1 : b1), 16);
        u32x4 o; if (odd) { o.x = rx; o.y = ry; o.z = b0; o.w = b1; } else { o.x = a0; o.y = a1; o.z = rx; o.w = ry; }
        *(u32x4*)(rowp_n0 + (odd ? 12 : 0)) = o; }
    __device__ __forceinline__ static void ld8pair(const bf16_t* rowp_n0, f32x4& h0, f32x4& h1, int fq) {
        const bool odd = fq & 1; const u32x4 w = __builtin_nontemporal_load((const u32x4*)(rowp_n0 + (odd ? 12 : 0)));
        const unsigned rx = (unsigned)__shfl_xor((int)(odd ? w.x : w.z), 16), ry = (unsigned)__shfl_xor((int)(odd ? w.y : w.w), 16);
        const unsigned n0x = odd ? rx : w.x, n0y = odd ? ry : w.y, n1x = odd ? w.z : rx, n1y = odd ? w.w : ry;
        h0 = (f32x4){__uint_as_float(n0x << 16), __uint_as_float(n0x & 0xffff0000u), __uint_as_float(n0y << 16), __uint_as_float(n0y & 0xffff0000u)};
        h1 = (f32x4){__uint_as_float(n1x << 16), __uint_as_float(n1x & 0xffff0000u), __uint_as_float(n1y << 16), __uint_as_float(n1y & 0xffff0000u)}; }
    const void* base; void* out; const float* ada; int gt_off; float coef; const float* g; int sh_off, sc_off; bf16_t* xb; float* ss; unsigned* cnt;
    __device__ __forceinline__ void fused(f32x4 (&acc)[2][2][4][2], const Unit& u, int wr, int wc, int fr, int fq, PG8_LAS unsigned char* lds, int wid, int lane) const {
        const float* ada_ = ada; const float* g_ = g; float coef_ = coef; float* ss_ = ss;
        asm volatile("" : "+s"(ada_), "+s"(g_), "+s"(coef_), "+s"(ss_));
        const int row0 = u.pm * BM + wr * 64 + fr, col0 = u.pn * BM + wc * 32 + 4 * fq; const float* adb = ada_ + (size_t)(u.pm >> 5) * 9216 + col0;
        {   f32x4 gv[2][2];
#pragma unroll
            for (int bj = 0; bj < 2; ++bj)
#pragma unroll
                for (int n = 0; n < 2; ++n) gv[bj][n] = *(const f32x4*)(adb + gt_off + bj * HALF + n * 16) * coef_;
            EPI_FOR_ROWS { const int row = row0 + ai * HALF + m * 16; const size_t off = (size_t)row * 1024 + col0; float q = 0.f;
#pragma unroll
                for (int bj = 0; bj < 2; ++bj) { f32x4 bsv[2];
                    if (BASE16) ld8pair((const bf16_t*)base + off + bj * HALF, bsv[0], bsv[1], fq);
                    else { bsv[0] = __builtin_nontemporal_load((const f32x4*)((const float*)base + off + bj * HALF)); bsv[1] = __builtin_nontemporal_load((const f32x4*)((const float*)base + off + bj * HALF + 16)); }
#pragma unroll
                    for (int n = 0; n < 2; ++n) { const f32x4 o = bsv[n] + gv[bj][n] * acc[ai][bj][m][n]; acc[ai][bj][m][n] = o;
                        q += (o[0] * o[0] + o[1] * o[1]) + (o[2] * o[2] + o[3] * o[3]); } }
                q += __shfl_xor(q, 16); q += __shfl_xor(q, 32); if (fq == 0) atomicAdd(ss_ + row, q);
                asm volatile("" ::: "memory"); }
        }
        asm volatile("s_waitcnt vmcnt(0)" ::: "memory");
        unsigned* c = cnt + 64 * u.pm;
        if (lane == 0) __hip_atomic_fetch_add(c, 1u, __ATOMIC_RELAXED, __HIP_MEMORY_SCOPE_AGENT);
        if (MODE == 0) {
            EPI_FOR_ROWS { const size_t off = (size_t)(row0 + ai * HALF + m * 16) * 1024 + col0;
#pragma unroll
                for (int bj = 0; bj < 2; ++bj) {
                    if (OUT16) st8pair((bf16_t*)out + off + bj * HALF, acc[ai][bj][m][0], acc[ai][bj][m][1], fq);
                    else {
#pragma unroll
                        for (int n = 0; n < 2; ++n) *(f32x4*)((float*)out + off + bj * HALF + n * 16) = acc[ai][bj][m][n]; } } } }
        if (wid == 0) { unsigned spins = 0; while (__hip_atomic_load(c, __ATOMIC_RELAXED, __HIP_MEMORY_SCOPE_AGENT) < 32u) { __builtin_amdgcn_s_sleep(1); if (++spins > (1u << 20)) break; } }
        __builtin_amdgcn_s_barrier();
        asm volatile("" ::: "memory");
        float rstd[2][4];
        EPI_FOR_ROWS rstd[ai][m] = 1.0f / sqrtf(__hip_atomic_load(ss_ + row0 + ai * HALF + m * 16, __ATOMIC_RELAXED, __HIP_MEMORY_SCOPE_AGENT) * (1.0f / 1024.0f) + 1e-6f);
        f32x4 gm[2][2], sh[2][2];
#pragma unroll
        for (int bj = 0; bj < 2; ++bj)
#pragma unroll
            for (int n = 0; n < 2; ++n) { const int cc = bj * HALF + n * 16; gm[bj][n] = *(const f32x4*)(g_ + col0 + cc);
                if (MODE == 0) { gm[bj][n] = gm[bj][n] * (*(const f32x4*)(adb + sc_off + cc) + 1.0f); sh[bj][n] = *(const f32x4*)(adb + sh_off + cc); } }
        EPI_FOR_ROWS { const size_t off = (size_t)(row0 + ai * HALF + m * 16) * 1024 + col0; const float r = rstd[ai][m];
#pragma unroll
            for (int bj = 0; bj < 2; ++bj) {
                if (MODE == 0) st8pair(xb + off + bj * HALF, acc[ai][bj][m][0] * r * gm[bj][0] + sh[bj][0], acc[ai][bj][m][1] * r * gm[bj][1] + sh[bj][1], fq);
                else {
#pragma unroll
                    for (int n = 0; n < 2; ++n) *(f32x4*)((float*)out + off + bj * HALF + n * 16) = acc[ai][bj][m][n] * r * gm[bj][n]; } } }
    }
};
#undef EPI_FOR_ROWS

template <class Epi, class Sched>
__device__ __forceinline__ void gemm_phase_naive(const Gemm g, const Sched& S, const Epi& E) {
    const int tid = threadIdx.x, wid = tid >> 6, lane = tid & 63, wr = wid >> 2, wc = wid & 3, fr = lane & 15, fq = lane >> 4;
    Unit cur;
    for (int ui = 0; S.next(ui, cur); ++ui) {
        f32x4 acc[2][2][4][2];
#pragma unroll
        for (int a = 0; a < 2; ++a)
#pragma unroll
            for (int b = 0; b < 2; ++b)
#pragma unroll
                for (int m = 0; m < 4; ++m)
#pragma unroll
                    for (int n = 0; n < 2; ++n) acc[a][b][m][n] = (f32x4){0.f, 0.f, 0.f, 0.f};
        const bf16_t* Ap = g.A + (size_t)(cur.pm * BM + wr * 64 + fr) * g.K;
        const bf16_t* Bp = g.Bt + (size_t)(cur.pn * BM + wc * 32 + (Epi::PERM ? 8 * fq : 4 * fq)) * g.K;
        for (int k = 0; k < g.K; ++k) {
            float av[2][4], bv[2][2][4];
#pragma unroll
            for (int a = 0; a < 2; ++a)
#pragma unroll
                for (int m = 0; m < 4; ++m) av[a][m] = __uint_as_float((unsigned)Ap[(size_t)(a * HALF + m * 16) * g.K + k] << 16);
#pragma unroll
            for (int b = 0; b < 2; ++b)
#pragma unroll
                for (int n = 0; n < 2; ++n)
#pragma unroll
                    for (int e = 0; e < 4; ++e) bv[b][n][e] = __uint_as_float((unsigned)Bp[(size_t)(b * HALF + (Epi::PERM ? 4 * n : 16 * n) + e) * g.K + k] << 16);
#pragma unroll
            for (int a = 0; a < 2; ++a)
#pragma unroll
                for (int b = 0; b < 2; ++b)
#pragma unroll
                    for (int m = 0; m < 4; ++m)
#pragma unroll
                        for (int n = 0; n < 2; ++n)
#pragma unroll
                            for (int e = 0; e < 4; ++e) acc[a][b][m][n][e] += av[a][m] * bv[b][n][e];
        }
        if constexpr (Epi::AFTER_DRAIN) E.fused(acc, cur, wr, wc, fr, fq, (PG8_LAS unsigned char*)nullptr, wid, lane); else E(acc, cur, wr, wc, fr, fq);
    }
}
}
#ifndef NAIVE_GEMM
#define NAIVE_GEMM 0
#endif
#ifndef MK_PER_PHASE
#define MK_PER_PHASE 0
#endif
constexpr int NWAVES = 8;
constexpr int N_PHASES = 11;

constexpr int BATCH = 2, T = 8192, D = 1024, FF = 2816, NADA = 9216, CH = 128, NH = 8;
constexpr int M = BATCH * T;
constexpr int NMIXA = 5120, NMIXB = 2048, NMIX = NMIXA + NMIXB;
constexpr float EPS = 1e-6f;
enum { I_X = 0, I_C, I_WADA, I_BADA, I_GFFN1, I_W1IN, I_W1OUT, I_GMIX, I_WMIXIN, I_CONVW, I_LNG, I_LNB, I_WSP, I_BSP, I_WAOUT, I_WBOUT, I_WMIXOUT, I_GFFN2, I_W2IN, I_W2OUT, I_GFINAL, N_IN };

constexpr size_t MiB = 1u << 20;
constexpr size_t WS_CTL = 0, CTL_ZERO_BYTES = 512 * 1024;
constexpr size_t WS_SS = 256 * 1024;
constexpr size_t WS_ADAP = 222 * MiB;
constexpr size_t WS_ADA = 3 * MiB;
constexpr size_t WS_BIASW = 3 * MiB + 512 * 1024;
constexpr size_t WS_VST = 4 * MiB;
constexpr size_t WS_WSP = 6 * MiB;
constexpr size_t WS_W1IN = 8 * MiB, WS_W1OUT = 19 * MiB, WS_WMIX = 25 * MiB, WS_WA = 39 * MiB, WS_WB = 41 * MiB, WS_WO = 43 * MiB, WS_W2IN = 45 * MiB, WS_W2OUT = 56 * MiB;
constexpr size_t WS_H = 62 * MiB;
constexpr size_t WS_ACT = 94 * MiB;
constexpr size_t WS_G = 222 * MiB;
constexpr size_t WS_END = WS_G + 32 * MiB;
static_assert(WS_W1IN + (size_t)2 * FF * D * 2 <= WS_W1OUT && WS_W1OUT + (size_t)D * FF * 2 <= WS_WMIX && WS_WMIX + (size_t)NMIX * D * 2 <= WS_WA && WS_W2IN + (size_t)2 * FF * D * 2 <= WS_W2OUT && WS_W2OUT + (size_t)D * FF * 2 <= WS_H, "d_ws map");
static_assert(WS_ADAP + (size_t)32 * 2 * NADA * 4 <= WS_END && WS_VST + (size_t)M * 32 * 4 <= WS_WSP && WS_END <= 256 * MiB, "d_ws map");
constexpr int CW_BAR = 1024;
constexpr int CW_CNT = 16384;

constexpr int RING_OFF = 0, RING_BYTES = 131072;
constexpr int LDSCTL_OFF = RING_BYTES, MISC_OFF = LDSCTL_OFF + 320;
constexpr int LDS_BYTES = 147456;
#define GAS __attribute__((address_space(1)))
#define LAS __attribute__((address_space(3)))
typedef unsigned short bf16;
typedef unsigned v4u __attribute__((ext_vector_type(4)));
typedef float f32x4 __attribute__((ext_vector_type(4)));
typedef short bf16x8 __attribute__((ext_vector_type(8)));
typedef GAS unsigned gu32;
typedef GAS unsigned long long gu64;
#define RLX_AGENT __ATOMIC_RELAXED, __HIP_MEMORY_SCOPE_AGENT
#define LDS_WAIT() asm volatile("s_waitcnt lgkmcnt(0)" ::: "memory")
#define VM_WAIT() asm volatile("s_waitcnt vmcnt(0)" ::: "memory")
__device__ __forceinline__ unsigned long long rt() { return __builtin_amdgcn_s_memrealtime(); }
__device__ __forceinline__ unsigned f2bf(float f) { unsigned u = __builtin_bit_cast(unsigned, f); return (u + 0x7fffu + ((u >> 16) & 1u)) >> 16; }
__device__ __forceinline__ unsigned pk2(float lo, float hi) { return pg8::cvt_pk_bf16(lo, hi); }
#define XB_TMO      128
#define XB_XCNT(j)  (256  + 64 * (j))
#define XB_XSUB(j)  (1280 + 64 * (j))
#define XB_XGEN(j)  (2304 + 64 * (j))
#define XB_TOP      3328
#define XB_TOPGEN   3392
#define XCD_BAR_WORDS 3456
#define XB_SPIN_CAP (1u << 18)

__device__ __forceinline__ unsigned xb_ld(unsigned* p)              { return __hip_atomic_load(p, __ATOMIC_RELAXED, __HIP_MEMORY_SCOPE_AGENT); }
__device__ __forceinline__ unsigned xb_add(unsigned* p, unsigned v) { return __hip_atomic_fetch_add(p, v, __ATOMIC_RELAXED, __HIP_MEMORY_SCOPE_AGENT); }
__device__ __forceinline__ unsigned xb_xcc_id() { return (unsigned)__builtin_amdgcn_s_getreg((3 << 11) | 20) & 0xFu; }
#define XB_SPIN(cond, bar) do { unsigned _sp = 0; while (cond) { __builtin_amdgcn_s_sleep(1); \
    if ((++_sp & 255u) == 0u) { if (xb_ld(&(bar)[XB_TMO])) break; if (_sp > XB_SPIN_CAP) { atomicAdd(&(bar)[XB_TMO], 1u); break; } } } } while (0)

struct XcdBarrier {
    unsigned* bar; unsigned x;
    volatile LAS unsigned* st;
};

__device__ __forceinline__ XcdBarrier xcd_barrier_post(unsigned* bar, volatile LAS unsigned* st) {
    XcdBarrier b; b.bar = bar; b.x = xb_xcc_id(); b.st = st;
    if (threadIdx.x == 0) (void)xb_add(&bar[XB_XCNT(b.x)], 1u);
    return b;
}
__device__ __forceinline__ void xcd_barrier_complete(unsigned* bar, unsigned x, unsigned& nloc, unsigned& nx) {
    const unsigned G = gridDim.x * gridDim.y * gridDim.z;
    unsigned sum, cnt, mine, sp = 0u;
    for (;;) {
        sum = 0u; cnt = 0u; mine = 0u;
#pragma unroll
        for (unsigned j = 0; j < 16; ++j) { const unsigned c = xb_ld(&bar[XB_XCNT(j)]); sum += c; cnt += (c > 0u) ? 1u : 0u; mine = (j == x) ? c : mine; }
        if (sum == G) break;
        __builtin_amdgcn_s_sleep(1);
        if ((++sp & 255u) == 0u) { if (xb_ld(&bar[XB_TMO])) break; if (sp > XB_SPIN_CAP) { atomicAdd(&bar[XB_TMO], 1u); break; } }
    }
    nloc = mine > 0u ? mine : 1u; nx = cnt > 0u ? cnt : 1u;
}

__device__ __forceinline__ void xcd_barrier(const XcdBarrier& b) {
    asm volatile("s_waitcnt vmcnt(0)" ::: "memory");
    __syncthreads();
    if (threadIdx.x == 0) {
        unsigned* bar = b.bar;
        __builtin_amdgcn_s_waitcnt(0);
        unsigned nloc = b.st[0], nx = b.st[1];
        if (nloc == 0u) { xcd_barrier_complete(bar, b.x, nloc, nx); b.st[0] = nloc; b.st[1] = nx; }
        const unsigned old = xb_add(&bar[XB_XSUB(b.x)], 1u);
        const unsigned gen = old / nloc;
        if (old + 1u == (gen + 1u) * nloc) {
            __builtin_amdgcn_fence(__ATOMIC_RELEASE, "agent");
            asm volatile("s_waitcnt vmcnt(0)" ::: "memory");
            const unsigned og = xb_add(&bar[XB_TOP], 1u);
            const unsigned tg = og / nx;
            if (og + 1u == (tg + 1u) * nx) xb_add(&bar[XB_TOPGEN], 1u);
            else XB_SPIN(xb_ld(&bar[XB_TOPGEN]) == tg, bar);
            __builtin_amdgcn_fence(__ATOMIC_ACQUIRE, "agent");
            asm volatile("s_waitcnt vmcnt(0)" ::: "memory");
        } else {
            XB_SPIN(xb_ld(&bar[XB_TOPGEN]) == gen, bar);
            __builtin_amdgcn_fence(__ATOMIC_ACQUIRE, "agent");
            asm volatile("s_waitcnt vmcnt(0)" ::: "memory");
        }
    }
    __syncthreads();
}
struct Frame {
    LAS unsigned char* lds;
    volatile LAS unsigned* MISC;
    gu32* ctl;
    int tid, lane, wave;
    int vcu, G;
};
__device__ __forceinline__ float wave_sum(float v) {
#pragma unroll
    for (int o = 1; o < 64; o <<= 1) v += __shfl_xor(v, o);
    return v;
}
__device__ __forceinline__ int dest_row(int mode, int n0) {
    if (mode == 1) { const int half = n0 / FF, j = n0 % FF; return 256 * (j / 128) + 128 * half + (j % 128); }
    if (mode == 2) { const int s = n0 / 1024, j = n0 % 1024;
        switch (s) { case 0: return NMIXA + j; case 1: return NMIXA + 1024 + j; case 2: return j; case 3: return 1024 + 256 * (j / 128) + (j % 128);
                     case 4: return 1024 + 256 * (j / 128) + 128 + (j % 128); case 5: return 3072 + j; default: return 4096 + j; } }
    return n0;
}
struct TrItem { const float* W; bf16* WT; int K, N, mode, item; };
__device__ __forceinline__ void tr_load(const TrItem& t, int tid, f32x4 (&v)[4]) {
    const int nblk = t.N / 128, kb = t.item / nblk, nb = t.item % nblk, k0 = 64 * kb, n0 = 128 * nb, lane = tid & 63, wv = tid >> 6;
#pragma unroll
    for (int i = 0; i < 4; ++i) { const int kk = 8 * wv + 2 * i + (lane >> 5); v[i] = __builtin_nontemporal_load((const GAS f32x4*)(t.W + (size_t)(k0 + kk) * t.N + n0 + 4 * (lane & 31))); }
}
__device__ __forceinline__ void tr_to_lds(LAS float* tile, int tid, const f32x4 (&v)[4]) {
    const int lane = tid & 63, wv = tid >> 6;
#pragma unroll
    for (int i = 0; i < 4; ++i) { const int kk = 8 * wv + 2 * i + (lane >> 5); LAS float* t = tile + kk * 129 + 4 * (lane & 31); t[0] = v[i].x; t[1] = v[i].y; t[2] = v[i].z; t[3] = v[i].w; }
}
__device__ __forceinline__ void tr_store(const TrItem& t, const LAS float* tile, int tid) {
    const int nblk = t.N / 128, kb = t.item / nblk, nb = t.item % nblk, k0 = 64 * kb, n0 = 128 * nb, r0 = dest_row(t.mode, n0);
#pragma unroll
    for (int j = 0; j < 2; ++j) { const int q = tid + 512 * j, n = q >> 3, c = q & 7; const LAS float* s = tile + (8 * c) * 129 + n;
        v4u o; o.x = pk2(s[0 * 129], s[1 * 129]); o.y = pk2(s[2 * 129], s[3 * 129]); o.z = pk2(s[4 * 129], s[5 * 129]); o.w = pk2(s[6 * 129], s[7 * 129]);
        *(GAS v4u*)(t.WT + (size_t)(r0 + n) * t.K + k0 + 8 * c) = o; }
}
struct Args { const float* in[N_IN]; float* out; unsigned char* ws; int ph_lo, ph_hi, li, pad; };

__device__ __forceinline__ void p0_prologue(Frame& F, const Args& A) {
    const int gw = F.vcu * NWAVES + F.wave, NGW = F.G * NWAVES;
    unsigned char* ws = A.ws;
    {
        constexpr int I_ADA = (NADA / 256) * 32;
        for (int r = gw; r < I_ADA; r += NGW) {
            const int nb = r / 32, kc = r % 32, n = 256 * nb + 4 * F.lane;
            const float s0v = pg8::fsilu(A.in[I_C][32 * kc + (F.lane & 31)]), s1v = pg8::fsilu(A.in[I_C][D + 32 * kc + (F.lane & 31)]);
            const float* wp = A.in[I_WADA] + (size_t)(32 * kc) * NADA + n; f32x4 a0 = {0.f, 0.f, 0.f, 0.f}, a1 = {0.f, 0.f, 0.f, 0.f};
#pragma unroll 16
            for (int kk = 0; kk < 32; ++kk) { const f32x4 w = __builtin_nontemporal_load((const GAS f32x4*)(wp + (size_t)kk * NADA)); a0 += w * __shfl(s0v, kk); a1 += w * __shfl(s1v, kk); }
            float* ap = (float*)(ws + WS_ADAP); *(f32x4*)(ap + (size_t)(kc * 2 + 0) * NADA + n) = a0; *(f32x4*)(ap + (size_t)(kc * 2 + 1) * NADA + n) = a1; }
        constexpr int I_SP = NH * CH;
        for (int r = gw; r < I_SP; r += NGW) { const int t = r % CH; const float* wp = A.in[I_WSP] + (size_t)r * CH + 2 * F.lane; const float w0 = wp[0], w1 = wp[1];
            ((unsigned*)(ws + WS_WSP))[(size_t)r * (CH / 2) + F.lane] = pk2(2 * F.lane <= t ? w0 : 0.f, 2 * F.lane + 1 <= t ? w1 : 0.f); }
    }
    LAS float* tile = (LAS float*)(F.lds + RING_OFF);
    constexpr int I_IN = (D / 64) * (2 * FF / 128), I_OUT = (FF / 64) * (D / 128), I_MIX = (D / 64) * (NMIX / 128), I_SQ = (D / 64) * (D / 128);
    constexpr int NITEMS = I_IN + I_OUT + I_MIX + 3 * I_SQ;
    auto decode = [&](int it) { TrItem t; int r = it;
        if (r < I_IN) { t = TrItem{A.in[I_W1IN], (bf16*)(ws + WS_W1IN), D, 2 * FF, 1, r}; return t; } r -= I_IN;
        if (r < I_OUT) { t = TrItem{A.in[I_W1OUT], (bf16*)(ws + WS_W1OUT), FF, D, 0, r}; return t; } r -= I_OUT;
        if (r < I_MIX) { t = TrItem{A.in[I_WMIXIN], (bf16*)(ws + WS_WMIX), D, NMIX, 2, r}; return t; } r -= I_MIX;
        if (r < I_SQ) { t = TrItem{A.in[I_WAOUT], (bf16*)(ws + WS_WA), D, D, 0, r}; return t; } r -= I_SQ;
        if (r < I_SQ) { t = TrItem{A.in[I_WBOUT], (bf16*)(ws + WS_WB), D, D, 0, r}; return t; } r -= I_SQ;
        t = TrItem{A.in[I_WMIXOUT], (bf16*)(ws + WS_WO), D, D, 0, r}; return t; };
    int it = F.vcu;
    if (it < NITEMS) { TrItem cur = decode(it); f32x4 v[4]; tr_load(cur, F.tid, v);
        for (;;) { tr_to_lds(tile, F.tid, v); __syncthreads();
            const int nit = it + F.G; TrItem nx = cur; const bool more = nit < NITEMS; if (more) { nx = decode(nit); tr_load(nx, F.tid, v); }
            tr_store(cur, tile, F.tid); __syncthreads();
            if (!more) break; cur = nx; it = nit; } }
}
__device__ __forceinline__ void p0_deferred(Frame& F, const Args& A, int idx, int nwg) {
    LAS float* tile = (LAS float*)(F.lds + RING_OFF);
    constexpr int I_IN = (D / 64) * (2 * FF / 128), I_OUT = (FF / 64) * (D / 128);
    auto decode = [&](int it) { TrItem t; if (it < I_IN) t = TrItem{A.in[I_W2IN], (bf16*)(A.ws + WS_W2IN), D, 2 * FF, 1, it}; else t = TrItem{A.in[I_W2OUT], (bf16*)(A.ws + WS_W2OUT), FF, D, 0, it - I_IN}; return t; };
    int it = idx;
    if (it < I_IN + I_OUT) { TrItem cur = decode(it); f32x4 v[4]; tr_load(cur, F.tid, v);
        for (;;) { tr_to_lds(tile, F.tid, v); __syncthreads();
            const int nit = it + nwg; TrItem nx = cur; const bool more = nit < I_IN + I_OUT; if (more) { nx = decode(nit); tr_load(nx, F.tid, v); }
            tr_store(cur, tile, F.tid); __syncthreads();
            if (!more) break; cur = nx; it = nit; } }
}
__device__ __forceinline__ void p1_phase(Frame& F, const Args& A) {
    LAS float* L = (LAS float*)(F.lds + RING_OFF);
    const float* ap = (const float*)(A.ws + WS_ADAP);
#pragma unroll 4
    for (int idx = F.tid; idx < 4096; idx += NWAVES * 64) { const int which = idx >> 11, b = (idx >> 10) & 1, c = idx & 1023;
        const int off = (which == 0 ? 0 : D) + c; float s = A.in[I_BADA][off];
#pragma unroll
        for (int kc = 0; kc < 32; ++kc) s += ap[(size_t)(kc * 2 + b) * NADA + off];
        L[idx] = s; }
    __syncthreads();
    const int gw = F.vcu * NWAVES + F.wave, NGW = F.G * NWAVES;
    {   const float* x = A.in[I_X]; bf16* xb = (bf16*)(A.ws + WS_H);
        for (int b = 0; b < BATCH; ++b) {
            f32x4 gm[4], sh[4];
#pragma unroll
            for (int j = 0; j < 4; ++j) { const int c = 4 * F.lane + 256 * j; const f32x4 gg = *(const f32x4*)(A.in[I_GFFN1] + c); const f32x4 sc = *(const LAS f32x4*)(L + 2048 + b * 1024 + c); gm[j] = gg * (sc + 1.0f); sh[j] = *(const LAS f32x4*)(L + b * 1024 + c); }
            for (int r0 = gw; r0 < T; r0 += 4 * NGW) {
                f32x4 v[4][4];
#pragma unroll
                for (int q = 0; q < 4; ++q) { const int r = r0 + q * NGW; const GAS f32x4* xr = (const GAS f32x4*)(x + ((size_t)b * T + (r < T ? r : r0)) * D) + F.lane;
#pragma unroll
                    for (int j = 0; j < 4; ++j) v[q][j] = __builtin_nontemporal_load(xr + 64 * j); }
#pragma unroll
                for (int q = 0; q < 4; ++q) { const int r = r0 + q * NGW; if (r >= T) break; const size_t m = (size_t)b * T + r; float s = 0.f;
#pragma unroll
                    for (int j = 0; j < 4; ++j) s += (v[q][j].x * v[q][j].x + v[q][j].y * v[q][j].y) + (v[q][j].z * v[q][j].z + v[q][j].w * v[q][j].w);
                    const float rstd = 1.f / sqrtf(wave_sum(s) * (1.f / D) + EPS);
                    GAS unsigned long long* o8 = (GAS unsigned long long*)(xb + m * D) + F.lane;
#pragma unroll
                    for (int j = 0; j < 4; ++j) { const f32x4 o = v[q][j] * rstd * gm[j] + sh[j]; o8[64 * j] = (unsigned long long)pk2(o.x, o.y) | ((unsigned long long)pk2(o.z, o.w) << 32); } }
            }
        }
    }
    {
        const int gt = F.vcu * NWAVES * 64 + F.tid;
        if (gt < 2 * NADA) { const int b = gt / NADA, n = gt % NADA; float s = A.in[I_BADA][n];
#pragma unroll
            for (int kc = 0; kc < 32; ++kc) s += ap[(size_t)(kc * 2 + b) * NADA + n];
            ((float*)(A.ws + WS_ADA))[gt] = s; }
    }
    __syncthreads();
}
__device__ __forceinline__ void final_norm_phase(Frame& F, const float* src, const float* g, float* dst) {
    const int gw = F.vcu * NWAVES + F.wave, NGW = F.G * NWAVES;
    f32x4 gg[4];
#pragma unroll
    for (int j = 0; j < 4; ++j) gg[j] = *(const f32x4*)(g + 4 * F.lane + 256 * j);
    for (int m = gw; m < M; m += NGW) {
        const GAS f32x4* xr = (const GAS f32x4*)(src + (size_t)m * D) + F.lane; f32x4 v[4]; float s = 0.f;
#pragma unroll
        for (int j = 0; j < 4; ++j) { v[j] = xr[64 * j]; s += (v[j].x * v[j].x + v[j].y * v[j].y) + (v[j].z * v[j].z + v[j].w * v[j].w); }
        const float rstd = 1.f / sqrtf(wave_sum(s) * (1.f / D) + EPS);
        GAS f32x4* o = (GAS f32x4*)(dst + (size_t)m * D) + F.lane;
#pragma unroll
        for (int j = 0; j < 4; ++j) o[64 * j] = v[j] * rstd * gg[j];
    }
}
__device__ __forceinline__ void mix_phase(Frame& F, const Args& A, bf16* dummy = nullptr) {
    constexpr int LTS = 136;
    LAS bf16* LT = (LAS bf16*)(F.lds + RING_OFF);
    LAS float* ST = (LAS float*)(F.lds + RING_OFF + 36864);
    bf16* BA = (bf16*)(A.ws + WS_ACT); bf16* Z = BA + (size_t)M * D; bf16* U = Z + (size_t)M * D; bf16* GV = U + (size_t)M * D;
    bf16* BAo = dummy ? dummy : BA; bf16* Uo = dummy ? dummy : U;
    const float* vst = (const float*)(A.ws + WS_VST); const bf16* wsp = (const bf16*)(A.ws + WS_WSP);
    const int cg = F.tid & 15, tr = F.tid >> 4, fr = F.lane & 15, fq = F.lane >> 4, w = F.wave;
    for (int un = blockIdx.x; un < BATCH * (T / CH) * NH; un += F.G) {
        const int h = un % NH, n = (un / NH) % (T / CH), b = un / (NH * (T / CH));
        const size_t R0 = (size_t)b * T + (size_t)n * CH; const int C0 = h * CH;
        if (F.tid < CH) { const float* p = vst + (R0 + F.tid) * 32; float s = 0.f, q = 0.f;
#pragma unroll
            for (int i = 0; i < 16; ++i) { s += p[2 * i]; q += p[2 * i + 1]; }
            const float mean = s * (1.f / D), var = q * (1.f / D) - mean * mean; ST[2 * F.tid] = mean; ST[2 * F.tid + 1] = 1.f / sqrtf(var + EPS); }
        __syncthreads();
        {
            float lg[8], lb[8];
#pragma unroll
            for (int e = 0; e < 8; ++e) { lg[e] = A.in[I_LNG][C0 + cg * 8 + e]; lb[e] = A.in[I_LNB][C0 + cg * 8 + e]; }
            LAS unsigned* LT32 = (LAS unsigned*)LT;
#pragma unroll
            for (int ip = 0; ip < 2; ++ip) { const int s = 4 * tr + 2 * ip;
                f32x4 a0, a1, b0, b1; pg8::load8(GV + (R0 + s) * D + C0 + cg * 8, a0, a1); pg8::load8(GV + (R0 + s + 1) * D + C0 + cg * 8, b0, b1);
                const float ma = ST[2 * s], ra = ST[2 * s + 1], mb = ST[2 * s + 2], rb = ST[2 * s + 3];
                const int sw = (((s >> 3) ^ cg) << 3) + (s & 7);
#pragma unroll
                for (int e = 0; e < 4; ++e) {
                    LT32[((cg * 8 + e) * LTS + sw) >> 1] = pk2((a0[e] - ma) * ra * lg[e] + lb[e], (b0[e] - mb) * rb * lg[e] + lb[e]);
                    LT32[((cg * 8 + 4 + e) * LTS + sw) >> 1] = pk2((a1[e] - ma) * ra * lg[4 + e] + lb[4 + e], (b1[e] - mb) * rb * lg[4 + e] + lb[4 + e]); } }
        }
        __syncthreads();
        {
            f32x4 acc[8];
#pragma unroll
            for (int cb = 0; cb < 8; ++cb) acc[cb] = (f32x4){0.f, 0.f, 0.f, 0.f};
            const bf16* wrow = wsp + ((size_t)h * CH + 16 * w + fr) * CH + 8 * fq;
            const int nk = (16 * w + 15) / 32 + 1;
            for (int kk = 0; kk < nk; ++kk) { const bf16x8 y = *(const bf16x8*)(wrow + 32 * kk);
#pragma unroll
                for (int cb = 0; cb < 8; ++cb) { const bf16x8 x = *(const LAS bf16x8*)(LT + (16 * cb + fr) * LTS + (((4 * kk + fq) ^ (2 * cb + (fr >> 3))) << 3)); acc[cb] = __builtin_amdgcn_mfma_f32_16x16x32_bf16(x, y, acc[cb], 0, 0, 0); } }
            const int t = 16 * w + fr; const float bias = A.in[I_BSP][h * CH + t]; const bool odd = fq & 1; const int c16 = odd ? 16 + 4 * (fq - 1) : 4 * fq;
            const bf16* up = U + (R0 + t) * D + C0 + c16; bf16* uo = Uo + (R0 + t) * D + C0 + c16;
            v4u uwv[4];
#pragma unroll
            for (int j = 0; j < 4; ++j) uwv[j] = *(const v4u*)(up + 32 * j);
#pragma unroll
            for (int j = 0; j < 4; ++j) { const v4u wv = uwv[j];
                const unsigned rx = (unsigned)__shfl_xor((int)(odd ? wv.x : wv.z), 16), ry = (unsigned)__shfl_xor((int)(odd ? wv.y : wv.w), 16);
                const unsigned ax = odd ? rx : wv.x, ay = odd ? ry : wv.y, bx = odd ? wv.z : rx, by = odd ? wv.w : ry;
                const f32x4 sa = acc[2 * j] + bias, sb = acc[2 * j + 1] + bias;
                const unsigned ra0 = pk2(__uint_as_float(ax << 16) * sa[0], __uint_as_float(ax & 0xffff0000u) * sa[1]), ra1 = pk2(__uint_as_float(ay << 16) * sa[2], __uint_as_float(ay & 0xffff0000u) * sa[3]);
                const unsigned rb0 = pk2(__uint_as_float(bx << 16) * sb[0], __uint_as_float(bx & 0xffff0000u) * sb[1]), rb1 = pk2(__uint_as_float(by << 16) * sb[2], __uint_as_float(by & 0xffff0000u) * sb[3]);
                const unsigned qx = (unsigned)__shfl_xor((int)(odd ? ra0 : rb0), 16), qy = (unsigned)__shfl_xor((int)(odd ? ra1 : rb1), 16);
                v4u o; if (odd) { o.x = qx; o.y = qy; o.z = rb0; o.w = rb1; } else { o.x = ra0; o.y = ra1; o.z = qx; o.w = qy; }
                *(v4u*)(uo + 32 * j) = o; }
        }
        {
            float w0[8], w1[8], w2[8];
#pragma unroll
            for (int e = 0; e < 8; ++e) { w0[e] = A.in[I_CONVW][C0 + cg * 8 + e]; w1[e] = A.in[I_CONVW][D + C0 + cg * 8 + e]; w2[e] = A.in[I_CONVW][2 * D + C0 + cg * 8 + e]; }
            const int t0 = 4 * tr; const size_t cofs = (size_t)C0 + cg * 8;
            v4u zr[6], br[4]; const bool head = (n == 0 && t0 == 0);
#pragma unroll
            for (int i = 0; i < 6; ++i) { const size_t row = (head && i < 2) ? R0 : R0 + t0 + i - 2; zr[i] = *(const v4u*)(Z + row * D + cofs); }
#pragma unroll
            for (int i = 0; i < 4; ++i) br[i] = *(const v4u*)(BA + (R0 + t0 + i) * D + cofs);
            f32x4 za[2], zb[2];
            pg8::unpack8(zr[0], za[0], za[1]); pg8::unpack8(zr[1], zb[0], zb[1]);
            if (head) { za[0] = za[1] = zb[0] = zb[1] = (f32x4){0.f, 0.f, 0.f, 0.f}; }
#pragma unroll
            for (int i = 0; i < 4; ++i) { f32x4 zc[2], ba[2]; pg8::unpack8(zr[2 + i], zc[0], zc[1]); pg8::unpack8(br[i], ba[0], ba[1]);
                f32x4 o[2];
#pragma unroll
                for (int hh = 0; hh < 2; ++hh)
#pragma unroll
                    for (int e = 0; e < 4; ++e) o[hh][e] = ba[hh][e] * (w0[4 * hh + e] * za[hh][e] + w1[4 * hh + e] * zb[hh][e] + w2[4 * hh + e] * zc[hh][e]);
                pg8::store8(BAo + (R0 + t0 + i) * D + cofs, o[0], o[1]);
                za[0] = zb[0]; za[1] = zb[1]; zb[0] = zc[0]; zb[1] = zc[1]; }
        }
        __syncthreads();
    }
}


#ifndef NAIVE_MIX
#define NAIVE_MIX 0
#endif
__device__ __forceinline__ void mix_phase_naive(Frame& F, const Args& A) {
    LAS float* ST = (LAS float*)(F.lds + RING_OFF);
    bf16* BA = (bf16*)(A.ws + WS_ACT); bf16* Z = BA + (size_t)M * D; bf16* U = Z + (size_t)M * D; bf16* GV = U + (size_t)M * D;
    auto ld = [](const bf16* p) { return __uint_as_float((unsigned)(*p) << 16); };
    for (int un = blockIdx.x; un < BATCH * (T / CH) * NH; un += F.G) {
        const int h = un % NH, n = (un / NH) % (T / CH), b = un / (NH * (T / CH));
        const size_t R0 = (size_t)b * T + (size_t)n * CH; const int C0 = h * CH;
        if (F.tid < CH) { float s = 0.f, q = 0.f; for (int c = 0; c < D; ++c) { const float v = ld(GV + (R0 + F.tid) * D + c); s += v; q += v * v; }
            const float mean = s / D, var = q / D - mean * mean; ST[2 * F.tid] = mean; ST[2 * F.tid + 1] = 1.f / sqrtf(var + EPS); }
        __syncthreads();
        for (int e = F.tid; e < CH * CH; e += NWAVES * 64) { const int t = e / CH, c = e % CH;
            float sv = A.in[I_BSP][h * CH + t];
            for (int s = 0; s <= t; ++s) sv += A.in[I_WSP][((size_t)h * CH + t) * CH + s] * ((ld(GV + (R0 + s) * D + C0 + c) - ST[2 * s]) * ST[2 * s + 1] * A.in[I_LNG][C0 + c] + A.in[I_LNB][C0 + c]);
            const float u = ld(U + (R0 + t) * D + C0 + c);
            float cv = 0.f;
            for (int k = 0; k < 3; ++k) { const int tt = n * CH + t - 2 + k; if (tt >= 0) cv += A.in[I_CONVW][k * D + C0 + c] * ld(Z + ((size_t)b * T + tt) * D + C0 + c); }
            const float ba = ld(BA + (R0 + t) * D + C0 + c);
            U[(R0 + t) * D + C0 + c] = (bf16)f2bf(u * sv); BA[(R0 + t) * D + C0 + c] = (bf16)f2bf(ba * cv); }
        __syncthreads();
    }
}

typedef pg8::EpiResidNorm<0, false, true> EpiRN_a; typedef pg8::EpiResidNorm<0, true, true> EpiRN_b; typedef pg8::EpiResidNorm<1, true, false> EpiRN_c;
__global__ void __launch_bounds__(NWAVES * 64, 2) fwd_kernel(Args args) {
    extern __shared__ __attribute__((aligned(16))) unsigned char lds[];
    Frame F;
    F.lds = (LAS unsigned char*)lds;
    F.MISC = (volatile LAS unsigned*)(F.lds + MISC_OFF);
    F.tid = threadIdx.x; F.lane = F.tid & 63; F.wave = __builtin_amdgcn_readfirstlane(F.tid >> 6);
    F.G = gridDim.x; { const int bx = blockIdx.x; F.vcu = (F.G % 8 == 0) ? (bx % 8) * (F.G / 8) + bx / 8 : bx; }
    unsigned char* ws = args.ws;
    F.ctl = (gu32*)(ws + WS_CTL);
    for (int u = F.tid; u < (LDS_BYTES - LDSCTL_OFF) / 4; u += NWAVES * 64) ((LAS unsigned*)(F.lds + LDSCTL_OFF))[u] = 0u;
    __syncthreads();
    XcdBarrier bar; bar.bar = (unsigned*)(F.ctl + CW_BAR); bar.x = 0; bar.st = nullptr;
    if (!MK_PER_PHASE) bar = xcd_barrier_post((unsigned*)(F.ctl + CW_BAR), F.MISC + 8);
    const int lo = args.ph_lo, hi = args.ph_hi;
#define IN(k) (lo <= (k) && (k) < hi)
#define SEAM(k) do { if (IN(k) && IN((k) + 1)) xcd_barrier(bar); } while (0)
    bf16* H = (bf16*)(ws + WS_H); bf16* HID = (bf16*)(ws + WS_ACT);
    bf16* BA = (bf16*)(ws + WS_ACT); bf16* Zb = BA + (size_t)M * D; bf16* Ub = Zb + (size_t)M * D; bf16* GVb = Ub + (size_t)M * D;
    const float* ada = (const float*)(ws + WS_ADA);
    float* xs = args.out;
#ifndef NAIVE_MASK
#define NAIVE_MASK 0
#endif
#define RUN_GEMM(ph, EPI, g, S, E) do { if ((NAIVE_MASK >> (ph)) & 1) pg8::gemm_phase_naive<EPI, pg8::StaticOrder>(g, S, E); else pg8::gemm_phase<EPI, pg8::StaticOrder, true, true>(F.lds + RING_OFF, g, S, E); } while (0)
    float* ss = (float*)(ws + WS_SS); unsigned* cnt = (unsigned*)(ws + WS_CTL) + CW_CNT;
    bf16* X1B = (bf16*)args.out;
    bf16* X2B = H;
    bf16* XB2 = GVb;
    if (IN(0)) { p0_prologue(F, args); } SEAM(0);
    if (IN(1)) { p1_phase(F, args); } SEAM(1);
    if (IN(2)) { pg8::Gemm g{H, (const bf16*)(ws + WS_W1IN), M, 2 * FF, D}; pg8::StaticOrder S; S.init(M, 2 * FF, F.G, (int)blockIdx.x);
        pg8::EpiSwiglu E{HID, FF}; RUN_GEMM(2, pg8::EpiSwiglu, g, S, E);
        { const int nfull = (M / 256) * (2 * FF / 256) % F.G;
          if (nfull > 0 && (int)blockIdx.x >= nfull) p0_deferred(F, args, (int)blockIdx.x - nfull, F.G - nfull);
          else if (nfull == 0) p0_deferred(F, args, (int)blockIdx.x, F.G); } } SEAM(2);
    if (IN(3)) { pg8::Gemm g{HID, (const bf16*)(ws + WS_W1OUT), M, D, FF}; pg8::StaticOrder S; S.init(M, D, F.G, (int)blockIdx.x);
        EpiRN_a E{args.in[I_X], X1B, ada, 2 * D, 0.5f, args.in[I_GMIX], 3 * D, 4 * D, H, ss, cnt}; RUN_GEMM(3, EpiRN_a, g, S, E); } SEAM(3);
    if (IN(4)) { pg8::Gemm g{H, (const bf16*)(ws + WS_WMIX), M, NMIXA, D}; pg8::StaticOrder S; S.init(M, NMIXA, F.G, (int)blockIdx.x);
        pg8::EpiMixA E{BA, Zb, Ub, GVb, (float*)(ws + WS_VST)}; RUN_GEMM(4, pg8::EpiMixA, g, S, E); } SEAM(4);
    if (IN(5)) {
#if NAIVE_MIX
        mix_phase_naive(F, args);
#else
        mix_phase(F, args);
#endif
    } SEAM(5);
#ifdef PROBE_BAR10
    for (int i = 0; i < 10; ++i) xcd_barrier(bar);
#endif
    if (IN(6)) { pg8::Gemm g{H, (const bf16*)(ws + WS_WMIX) + (size_t)NMIXA * D, M, NMIXB, D}; pg8::StaticOrder S; S.init(M, NMIXB, F.G, (int)blockIdx.x);
        pg8::EpiGates E{Zb, GVb}; RUN_GEMM(6, pg8::EpiGates, g, S, E); }
    if (IN(6) && IN(7) && F.G != 256) xcd_barrier(bar);
    if (IN(7)) { pg8::Gemm g{BA, (const bf16*)(ws + WS_WA), M, D, D, Ub, (const bf16*)(ws + WS_WB)}; pg8::DualOrder S; S.base.init(M, D, F.G, (int)blockIdx.x);
        pg8::EpiDualGate E{Zb, GVb, (bf16*)(ws + WS_G)};
        if ((NAIVE_MASK >> 7) & 1) pg8::gemm_phase_naive<pg8::EpiDualGate, pg8::DualOrder>(g, S, E); else pg8::gemm_phase<pg8::EpiDualGate, pg8::DualOrder, true, true>(F.lds + RING_OFF, g, S, E); } SEAM(7);
    if (IN(8)) { pg8::Gemm g{(const bf16*)(ws + WS_G), (const bf16*)(ws + WS_WO), M, D, D}; pg8::StaticOrder S; S.init(M, D, F.G, (int)blockIdx.x);
        EpiRN_b E{X1B, X2B, ada, 5 * D, 1.0f, args.in[I_GFFN2], 6 * D, 7 * D, XB2, ss + M, cnt + 4096}; RUN_GEMM(8, EpiRN_b, g, S, E); } SEAM(8);
    if (IN(9)) { pg8::Gemm g{XB2, (const bf16*)(ws + WS_W2IN), M, 2 * FF, D}; pg8::StaticOrder S; S.init(M, 2 * FF, F.G, (int)blockIdx.x);
        pg8::EpiSwiglu E{HID, FF}; RUN_GEMM(9, pg8::EpiSwiglu, g, S, E); } SEAM(9);
    if (IN(10)) { pg8::Gemm g{HID, (const bf16*)(ws + WS_W2OUT), M, D, FF}; pg8::StaticOrder S; S.init(M, D, F.G, (int)blockIdx.x);
        EpiRN_c E{X2B, xs, ada, 8 * D, 0.5f, args.in[I_GFINAL], 0, 0, nullptr, ss + 2 * M, cnt + 8192}; RUN_GEMM(10, EpiRN_c, g, S, E); }
#undef IN
#undef SEAM
}

extern "C" void kernel_launch(void* const* d_in, const int* in_sizes, int n_in, void* d_out, int out_size, void* d_ws, size_t ws_size, hipStream_t stream) {
    static int grid = 0;
    if (grid == 0) {
        if (n_in != N_IN || in_sizes[0] != M * D || out_size != M * D || ws_size < WS_END) { fprintf(stderr, "kernel_launch: unexpected shapes (n_in %d, in0 %d, out %d, ws %zu)\n", n_in, n_in > 0 ? in_sizes[0] : -1, out_size, ws_size); grid = -1; return; }
        int dev = 0, cus = 0, per_cu = 0;
        if (hipGetDevice(&dev) != hipSuccess || hipDeviceGetAttribute(&cus, hipDeviceAttributeMultiprocessorCount, dev) != hipSuccess) { grid = -1; return; }
        if (hipFuncSetAttribute((const void*)fwd_kernel, hipFuncAttributeMaxDynamicSharedMemorySize, LDS_BYTES) != hipSuccess) { fprintf(stderr, "kernel_launch: hipFuncSetAttribute failed\n"); grid = -1; return; }
        if (hipOccupancyMaxActiveBlocksPerMultiprocessor(&per_cu, (const void*)fwd_kernel, NWAVES * 64, LDS_BYTES) != hipSuccess || per_cu < 1) { fprintf(stderr, "kernel_launch: occupancy query reports %d workgroups per CU\n", per_cu); per_cu = 1; }
        (void)hipGetLastError();
        grid = cus;
    }
    if (grid < 0) return;
    (void)hipMemsetAsync((char*)d_ws + WS_CTL, 0, CTL_ZERO_BYTES, stream);
    Args a{};
    for (int i = 0; i < N_IN; ++i) a.in[i] = (const float*)d_in[i];
    a.out = (float*)d_out; a.ws = (unsigned char*)d_ws;
#if MK_PER_PHASE
    for (int p = 0; p < N_PHASES; ++p) { a.ph_lo = p; a.ph_hi = p + 1; a.li = p; hipLaunchKernelGGL(fwd_kernel, dim3(grid), dim3(NWAVES * 64), LDS_BYTES, stream, a); }
#else
    a.ph_lo = 0; a.ph_hi = N_PHASES; a.li = 0;
    hipLaunchKernelGGL(fwd_kernel, dim3(grid), dim3(NWAVES * 64), LDS_BYTES, stream, a);
#ifdef PROBE_NREP
    for (int rep = 1; rep < PROBE_NREP; ++rep) { (void)hipMemsetAsync((char*)d_ws + WS_CTL, 0, CTL_ZERO_BYTES, stream); hipLaunchKernelGGL(fwd_kernel, dim3(grid), dim3(NWAVES * 64), LDS_BYTES, stream, a); }
#endif
#endif
}
```
